# Optimizing an MI355X kernel written in HIP

```python
import jax, jax.numpy as jnp
from jax import lax
import numpy as np

D_MODEL = 1024
BATCH = 8
SEQ = 2048
DEPTH = 4
DEC_BATCH = 128
DEC_SEQ = 4
PAST_LEN = 16384
PAGE_SIZE = 128

N_META = 16
D_MIX = D_MODEL
D_POOL = D_MIX // 2
D_REC = D_MIX - D_POOL
POOL_WINDOWS = (2, 4, 8, 16)
N_POOL_GROUPS = len(POOL_WINDOWS)
POOL_GROUP = D_POOL // N_POOL_GROUPS
POOL_BUF = max(POOL_WINDOWS) - 1
REC_HEAD_F = 128
N_REC_HEADS = D_REC // REC_HEAD_F
REC_HEAD_I = D_REC // N_REC_HEADS
REC_CHUNK = 64
D_FF = 2816
CONV_W = 3
D_IN = D_POOL + 4 * D_REC
EPS = 1e-6

kernel_name = 'hymba_pool_hgrn2_convffn_step'


def rmsnorm(x, g):
    xf = x.astype(jnp.float32)
    y = xf * lax.rsqrt(jnp.mean(xf * xf, axis=-1, keepdims=True) + EPS)
    return (y * g.astype(jnp.float32)).astype(x.dtype)


def pool_mix(u, prev, start, w_pool, scale):
    N, T, _ = u.shape
    uf = u.astype(jnp.float32)
    ext = jnp.concatenate([prev.astype(jnp.float32), uf], axis=1)
    c = jnp.concatenate([jnp.zeros((N, 1, D_POOL), jnp.float32), jnp.cumsum(ext, axis=1)], axis=1)
    pos = start + jnp.arange(T)
    P = POOL_BUF
    outs = []
    for gi, w in enumerate(POOL_WINDOWS):
        cs = c[:, :, gi * POOL_GROUP:(gi + 1) * POOL_GROUP]
        win_sum = cs[:, P + 1:P + 1 + T] - cs[:, P + 1 - w:P + 1 - w + T]
        cnt = jnp.minimum(pos + 1, w).astype(jnp.float32)
        outs.append(win_sum / cnt[None, :, None] - uf[:, :, gi * POOL_GROUP:(gi + 1) * POOL_GROUP])
    m = jnp.stack(outs, axis=2)
    y = jnp.einsum('ntgc,gcd->ntgd', m, w_pool.astype(jnp.float32)).reshape(N, T, D_POOL)
    y = y * scale.astype(jnp.float32)
    return y.astype(u.dtype), ext[:, -POOL_BUF:].astype(prev.dtype)


def gla_chunk(S, q, k, g, v):
    C = q.shape[2]
    G = jnp.cumsum(g, axis=2)
    causal = jnp.tril(jnp.ones((C, C), bool))
    diff = G[:, :, :, None, :] - G[:, :, None, :, :]
    decay = jnp.exp(jnp.where(causal[:, :, None], diff, -jnp.inf))
    A = jnp.einsum('nhtd,nhsd,nhtsd->nhts', q, k, decay)
    o = jnp.einsum('nhts,nhsv->nhtv', A, v) + jnp.einsum('nhtd,nhdv->nhtv', q * jnp.exp(G), S)
    G_last = G[:, :, -1:, :]
    S_new = jnp.exp(G_last[:, :, 0, :])[..., None] * S + jnp.einsum('nhsd,nhsv->nhdv', k * jnp.exp(G_last - G), v)
    return o, S_new


def hgrn2_mix(z, S0, lb, g_norm, lead):
    N, T, _ = z.shape
    zf = z.astype(jnp.float32)
    q, f, i, gate = jnp.split(zf, 4, axis=-1)
    q = jax.nn.silu(q) * REC_HEAD_F ** -0.5
    log_f = jnp.logaddexp(jnp.log(lb), jnp.log1p(-lb) + jax.nn.log_sigmoid(f))
    k = (1.0 - lb) * jax.nn.sigmoid(-f)
    heads = lambda a, d: a.reshape(N, T, N_REC_HEADS, d).transpose(0, 2, 1, 3)
    q, k, log_f = heads(q, REC_HEAD_F), heads(k, REC_HEAD_F), heads(log_f, REC_HEAD_F)
    v = heads(i, REC_HEAD_I)
    S = S0.astype(jnp.float32)
    o, S = gla_chunk(S, q[:, :, :lead], k[:, :, :lead], log_f[:, :, :lead], v[:, :, :lead])
    rest = T - lead
    if rest > 0:
        n_c = rest // REC_CHUNK
        blocks = lambda a: a[:, :, lead:].reshape(N, N_REC_HEADS, n_c, REC_CHUNK, a.shape[-1]).transpose(2, 0, 1, 3, 4)

        def step(S, xs):
            o_c, S = gla_chunk(S, *xs)
            return S, o_c

        S, o_rest = lax.scan(step, S, (blocks(q), blocks(k), blocks(log_f), blocks(v)))
        o_rest = o_rest.transpose(1, 2, 0, 3, 4).reshape(N, N_REC_HEADS, rest, REC_HEAD_I)
        o = jnp.concatenate([o, o_rest], axis=2)
    o = o.transpose(0, 2, 1, 3)
    o = o * lax.rsqrt(jnp.mean(o * o, axis=-1, keepdims=True) + EPS) * g_norm.astype(jnp.float32)
    o = o.reshape(N, T, D_REC) * jax.nn.silu(gate)
    return o.astype(z.dtype), S


def conv_ffn(h, prev, w_a, w_b, conv_w, conv_b, w_down):
    T = h.shape[1]
    a = h @ w_a
    b = h @ w_b
    ext = jnp.concatenate([prev.astype(a.dtype), a], axis=1)
    ac = conv_b + sum(conv_w[j] * ext[:, j:j + T] for j in range(CONV_W))
    y = (jax.nn.gelu(ac, approximate=False) * b) @ w_down
    return y, ext[:, -(CONV_W - 1):].astype(prev.dtype)


def trunk_layer(x, pool_prev, pool_start, S0, conv_prev, lead, n1, w_in, w_pool, pool_scale, lb, g_norm,
                w_out, n2, w_a, w_b, conv_w, conv_b, w_down):
    h = rmsnorm(x, n1)
    z = h @ w_in
    y_pool, pool_new = pool_mix(z[..., :D_POOL], pool_prev, pool_start, w_pool, pool_scale)
    y_rec, S_new = hgrn2_mix(z[..., D_POOL:], S0, lb, g_norm, lead)
    x = x + jnp.concatenate([y_pool, y_rec], axis=-1) @ w_out
    y_ffn, conv_new = conv_ffn(rmsnorm(x, n2), conv_prev, w_a, w_b, conv_w, conv_b, w_down)
    return x + y_ffn, pool_new, S_new, conv_new


def setup_inputs(seed: int = 0) -> dict:
    key = jax.random.key(seed)
    ks = jax.random.split(key, 21)
    nrm = lambda k, shape, s: jax.random.normal(k, shape, jnp.float32) * s
    return {
        'x_prompt': nrm(ks[0], (BATCH, SEQ, D_MODEL), 1.0),
        'x_sample': nrm(ks[1], (DEC_BATCH, DEC_SEQ, D_MODEL), 1.0),
        'state_pool': nrm(ks[2], (DEPTH, DEC_BATCH, POOL_BUF, D_POOL), 1.0),
        'state_rec': nrm(ks[3], (DEPTH, DEC_BATCH, N_REC_HEADS, REC_HEAD_F, REC_HEAD_I), 0.3),
        'state_conv': nrm(ks[4], (DEPTH, DEC_BATCH, CONV_W - 1, D_FF), 1.0),
        'meta_tokens': nrm(ks[5], (N_META, D_MODEL), 1.0),
        'norm1_g': 1.0 + nrm(ks[6], (DEPTH, D_MODEL), 0.02),
        'w_in': nrm(ks[7], (DEPTH, D_MODEL, D_IN), D_MODEL ** -0.5),
        'w_pool': nrm(ks[8], (DEPTH, N_POOL_GROUPS, POOL_GROUP, POOL_GROUP), POOL_GROUP ** -0.5),
        'pool_scale': 1.0 + nrm(ks[9], (DEPTH, D_POOL), 0.02),
        'lb_raw': nrm(ks[10], (DEPTH, D_REC), 0.1),
        'rec_norm_g': 1.0 + nrm(ks[11], (DEPTH, REC_HEAD_I), 0.02),
        'w_out': nrm(ks[12], (DEPTH, D_MIX, D_MODEL), D_MIX ** -0.5),
        'norm2_g': 1.0 + nrm(ks[13], (DEPTH, D_MODEL), 0.02),
        'w_a': nrm(ks[14], (DEPTH, D_MODEL, D_FF), D_MODEL ** -0.5),
        'w_b': nrm(ks[15], (DEPTH, D_MODEL, D_FF), D_MODEL ** -0.5),
        'conv_w': nrm(ks[16], (DEPTH, CONV_W, D_FF), CONV_W ** -0.5),
        'conv_b': nrm(ks[17], (DEPTH, D_FF), 0.01),
        'w_down': nrm(ks[18], (DEPTH, D_FF, D_MODEL), D_FF ** -0.5),
        'final_g': 1.0 + nrm(ks[19], (D_MODEL,), 0.02),
    }


def reference(x_prompt, x_sample, state_pool, state_rec, state_conv, meta_tokens, norm1_g, w_in, w_pool,
              pool_scale, lb_raw, rec_norm_g, w_out, norm2_g, w_a, w_b, conv_w, conv_b, w_down, final_g):
    lb_all = jnp.cumsum(jax.nn.softmax(lb_raw.astype(jnp.float32), axis=0), axis=0)
    lb_all = lb_all - lb_all[:1]
    B = x_prompt.shape[0]
    xp = jnp.concatenate([jnp.broadcast_to(meta_tokens[None].astype(x_prompt.dtype), (B, N_META, D_MODEL)), x_prompt], axis=1)
    xs = x_sample
    pool_p0 = jnp.zeros((B, POOL_BUF, D_POOL), state_pool.dtype)
    rec_p0 = jnp.zeros((B, N_REC_HEADS, REC_HEAD_F, REC_HEAD_I), jnp.float32)
    conv_p0 = jnp.zeros((B, CONV_W - 1, D_FF), state_conv.dtype)
    pool_p, rec_p, conv_p, pool_s, rec_s, conv_s = [], [], [], [], [], []
    for l in range(DEPTH):
        lp = (norm1_g[l], w_in[l], w_pool[l], pool_scale[l], lb_all[l], rec_norm_g[l], w_out[l], norm2_g[l],
              w_a[l], w_b[l], conv_w[l], conv_b[l], w_down[l])
        xp, pp, sp, cp = trunk_layer(xp, pool_p0, 0, rec_p0, conv_p0, N_META, *lp)
        xs, ps, ss, cs = trunk_layer(xs, state_pool[l], PAST_LEN, state_rec[l], state_conv[l], xs.shape[1], *lp)
        pool_p.append(pp); rec_p.append(sp.astype(state_rec.dtype)); conv_p.append(cp)
        pool_s.append(ps); rec_s.append(ss.astype(state_rec.dtype)); conv_s.append(cs)
    y_prompt = rmsnorm(xp, final_g)[:, N_META:]
    y_sample = rmsnorm(xs, final_g)
    return (y_prompt, y_sample, jnp.stack(pool_p), jnp.stack(rec_p), jnp.stack(conv_p),
            jnp.stack(pool_s), jnp.stack(rec_s), jnp.stack(conv_s))
```

```cpp
#include <hip/hip_runtime.h>
#include <cstdio>
#include <cstdint>
namespace pg8 {
#define PG8_LAS __attribute__((address_space(3)))
typedef unsigned short bf16_t;
typedef short bf16x8 __attribute__((ext_vector_type(8)));
typedef float f32x4 __attribute__((ext_vector_type(4)));
typedef unsigned u32x4 __attribute__((ext_vector_type(4)));
constexpr int BM = 256, BK = 64, HALF = 128, HTB = HALF * BK * 2  , STAGE_BYTES = 8 * HTB, NXCD = 8, WGM = 8;

__host__ __device__ __forceinline__ int lds_byte(int r, int c) { const int st = (r >> 4) * 2 + (c >> 5), rr = r & 15, cc = c & 31, ob = rr * 64 + cc * 2; return st * 1024 + (ob ^ (((ob >> 9) & 1) << 5)); }
__host__ __device__ __forceinline__ void stage_rc(int b, int& R, int& C) { const int st = b / 1024, sb = b % 1024, swz = sb ^ (((sb >> 9) & 1) << 5); R = (st >> 1) * 16 + swz / 64; C = (st & 1) * 32 + (swz % 64) / 2; }
__host__ __device__ __forceinline__ int perm32(int rho) { const int n = rho >> 4, i = rho & 15; return 8 * (i >> 2) + 4 * n + (i & 3); }

struct Unit { int pm, pn; };
struct Gemm { const bf16_t* A; const bf16_t* Bt; int M, N, K; };

struct StaticOrder {
    int nM, nN, nwg, G, c;
    __host__ __device__ void init(int M, int N, int G_, int c_) { nM = M / BM; nN = N / BM; nwg = nM * nN; G = G_; c = c_; }
    __host__ __device__ bool next(int i, Unit& u) const {
        const long L = (long)i * G + c; if (L >= nwg) return false;
        int wgid = (int)L; { const int q = nwg / NXCD, r = nwg % NXCD, xcd = wgid % NXCD, off = wgid / NXCD; wgid = (xcd < r ? xcd * (q + 1) : r * (q + 1) + (xcd - r) * q) + off; }
        const int nig = WGM * nN, gid = wgid / nig, fm = gid * WGM, gsz = (nM - fm) < WGM ? (nM - fm) : WGM;
        u.pm = fm + ((wgid % nig) % gsz); u.pn = (wgid % nig) / gsz; return true;
    }
    __device__ __forceinline__ void a_ready(const Unit&) const {}
    __device__ __forceinline__ void done(const Unit&) const {}
};

__device__ __forceinline__ unsigned cvt_pk_bf16(float lo, float hi) { unsigned r; asm volatile("v_cvt_pk_bf16_f32 %0, %1, %2" : "=v"(r) : "v"(lo), "v"(hi)); return r; }
typedef float f32x2 __attribute__((ext_vector_type(2)));
__device__ __forceinline__ f32x2 gelu_pk(f32x2 v) {
    const f32x2 av = __builtin_elementwise_abs(v), d = av * 0.2316418882f + 1.0f;
    f32x2 t; t.x = __builtin_amdgcn_rcpf(d.x); t.y = __builtin_amdgcn_rcpf(d.y);
    f32x2 q = t * 0.5307027145f + (-0.7265760135f); q = q * t + 0.7107068705f; q = q * t + (-0.142248368f); q = q * t + 0.127414796f; q = q * t;
    const f32x2 s = (v * v) * (-0.72134752044f);
    f32x2 e; e.x = __builtin_amdgcn_exp2f(s.x); e.y = __builtin_amdgcn_exp2f(s.y);
    const f32x2 m = v * (q * e), r = v - m;
    f32x2 o; o.x = v.x < 0.f ? m.x : r.x; o.y = v.y < 0.f ? m.y : r.y; return o;
}

constexpr float RMS_EPS = 1e-6f;
typedef unsigned u32x2 __attribute__((ext_vector_type(2)));

struct EpiScaleBf16 {
    static constexpr bool PERM = true, AFTER_DRAIN = false;
    bf16_t* O; int ldc; const float* ssq;
    __device__ __forceinline__ void operator()(const f32x4 (&acc)[2][2][4][2], const Unit& u, int wr, int wc, int fr, int fq) const {
        const int row0 = u.pm * BM + wr * 64 + fr, col0 = u.pn * BM + wc * 32 + 8 * fq;
#pragma unroll
        for (int ai = 0; ai < 2; ++ai)
#pragma unroll
            for (int m = 0; m < 4; ++m) {
                const int r = row0 + ai * HALF + m * 16;
                const f32x4 q0 = *(const f32x4*)(ssq + (size_t)r * 16), q1 = *(const f32x4*)(ssq + (size_t)r * 16 + 4), q2 = *(const f32x4*)(ssq + (size_t)r * 16 + 8), q3 = *(const f32x4*)(ssq + (size_t)r * 16 + 12);
                const float sq = (((q0[0] + q0[1]) + (q0[2] + q0[3])) + ((q1[0] + q1[1]) + (q1[2] + q1[3]))) + (((q2[0] + q2[1]) + (q2[2] + q2[3])) + ((q3[0] + q3[1]) + (q3[2] + q3[3])));
                const float rs = 1.0f / sqrtf(sq * (1.0f / 1024.0f) + RMS_EPS);
                bf16_t* rowp = O + (size_t)r * ldc + col0;
#pragma unroll
                for (int bj = 0; bj < 2; ++bj) {
                    const f32x4 v0 = acc[ai][bj][m][0] * rs, v1 = acc[ai][bj][m][1] * rs;
                    u32x4 w; w.x = cvt_pk_bf16(v0[0], v0[1]); w.y = cvt_pk_bf16(v0[2], v0[3]); w.z = cvt_pk_bf16(v1[0], v1[1]); w.w = cvt_pk_bf16(v1[2], v1[3]);
                    *(u32x4*)(rowp + bj * HALF) = w;
                }
            }
    }
};

struct EpiRes {
    static constexpr bool PERM = false, AFTER_DRAIN = false;
    float* X; bf16_t* XB; float* ssq;
    __device__ __forceinline__ void operator()(const f32x4 (&acc)[2][2][4][2], const Unit& u, int wr, int wc, int fr, int fq) const {
        const int col0 = u.pn * BM + wc * 32 + 4 * fq;
#pragma unroll
        for (int ai = 0; ai < 2; ++ai)
#pragma unroll
            for (int m = 0; m < 4; ++m) {
                const int r = u.pm * BM + ai * HALF + wr * 64 + m * 16 + fr;
                const size_t off = (size_t)r * 1024 + col0;
                float s = 0.f;
#pragma unroll
                for (int bj = 0; bj < 2; ++bj)
#pragma unroll
                    for (int n = 0; n < 2; ++n) {
                        float* px = X + off + bj * HALF + n * 16;
                        const f32x4 x = *(const f32x4*)px + acc[ai][bj][m][n];
                        *(f32x4*)px = x;
                        s += (x[0] * x[0] + x[1] * x[1]) + (x[2] * x[2] + x[3] * x[3]);
                        u32x2 w; w.x = cvt_pk_bf16(x[0], x[1]); w.y = cvt_pk_bf16(x[2], x[3]);
                        *(u32x2*)(XB + off + bj * HALF + n * 16) = w;
                    }
                s += __shfl_xor(s, 16); s += __shfl_xor(s, 32);
                if (fq == 0) ssq[(size_t)r * 16 + u.pn * 4 + wc] = s;
                asm volatile("" ::: "memory");
            }
    }
};
template <class Epi, class Sched, bool ALIGN_EPI = false, bool SP2 = false>
__device__ __forceinline__ void gemm_phase(PG8_LAS unsigned char* lds, const Gemm g, const Sched& S, const Epi& E) {
    int tid_ = threadIdx.x; asm volatile("" : "+v"(tid_));
    const int tid = tid_, wid = __builtin_amdgcn_readfirstlane(tid >> 6), lane = tid & 63, wr = wid >> 2, wc = wid & 3, fr = lane & 15, fq = lane >> 4;
    const int K = g.K, nt = K / BK;
    unsigned voffA[2], voffB[2];
#pragma unroll
    for (int i = 0; i < 2; ++i) { int R, C; stage_rc(tid * 16 + i * 8192, R, C); const int Rb = Epi::PERM ? ((R & ~31) + perm32(R & 31)) : R;
        voffA[i] = (unsigned)(R * K + C) * 2u; voffB[i] = (unsigned)(Rb * K + C) * 2u; }
    const size_t kstep = (size_t)(BK * 2);
    const size_t hstep = (size_t)HALF * K * 2;
    const size_t tstep = 2 * hstep;
    const unsigned ldsw = (unsigned)wid * 1024u;
    const int aoff = lds_byte(wr * 64 + fr, fq * 8), boff = lds_byte(wc * 32 + fr, fq * 8);
#define PG8_SA(b, h) (((b) * 2 + (h)) * HTB)
#define PG8_SB(b, h) ((4 + (b) * 2 + (h)) * HTB)
#define PG8_STAGE(bufoff, gbase, voff) do { _Pragma("unroll") for (int _i = 0; _i < 2; ++_i) \
        __builtin_amdgcn_global_load_lds((const unsigned*)((const char*)(gbase) + (voff)[_i]), (PG8_LAS unsigned*)(lds + (bufoff) + ldsw + _i * 8192), 16, 0, 0); } while (0)
#define PG8_LDA(dst, b, h) do { _Pragma("unroll") for (int m = 0; m < 4; ++m) _Pragma("unroll") for (int k = 0; k < 2; ++k) dst[m][k] = *(const PG8_LAS bf16x8*)(lds + PG8_SA(b, h) + aoff + m * 2048 + k * 1024); } while (0)
#define PG8_LDB(dst, b, h) do { _Pragma("unroll") for (int n = 0; n < 2; ++n) _Pragma("unroll") for (int k = 0; k < 2; ++k) dst[n][k] = *(const PG8_LAS bf16x8*)(lds + PG8_SB(b, h) + boff + n * 2048 + k * 1024); } while (0)
#define PG8_MMA(ai, bj, At, Bt) do { __builtin_amdgcn_s_setprio(1); _Pragma("unroll") for (int m = 0; m < 4; ++m) _Pragma("unroll") for (int n = 0; n < 2; ++n) _Pragma("unroll") for (int k = 0; k < 2; ++k) \
        acc[ai][bj][m][n] = __builtin_amdgcn_mfma_f32_16x16x32_bf16(Bt[n][k], At[m][k], acc[ai][bj][m][n], 0, 0, 0); __builtin_amdgcn_s_setprio(0); } while (0)
#define PG8_WAIT_V(n) asm volatile("s_waitcnt vmcnt(" #n ")" ::: "memory")
#define PG8_WAIT_L(n) asm volatile("s_waitcnt lgkmcnt(" #n ")" ::: "memory")
#define PG8_BAR __builtin_amdgcn_s_barrier()
#define PG8_SCHED __builtin_amdgcn_sched_barrier(0)
    Unit cur, nxt; int ui = 0;
    if (!S.next(0, cur)) return;
    f32x4 acc[2][2][4][2];
#pragma unroll
    for (int a = 0; a < 2; ++a)
#pragma unroll
        for (int b = 0; b < 2; ++b)
#pragma unroll
            for (int m = 0; m < 4; ++m)
#pragma unroll
                for (int n = 0; n < 2; ++n) acc[a][b][m][n] = (f32x4){0.f, 0.f, 0.f, 0.f};
    bf16x8 At[4][2], B0[2][2], B1[2][2];
    const char* cA = (const char*)g.A + (size_t)cur.pm * tstep; const char* cB = (const char*)g.Bt + (size_t)cur.pn * tstep;
    S.a_ready(cur);
    if constexpr (SP2) {
        PG8_STAGE(PG8_SB(0, 0), cB, voffB); PG8_STAGE(PG8_SB(0, 1), cB + hstep, voffB); PG8_STAGE(PG8_SA(0, 0), cA, voffA); PG8_STAGE(PG8_SA(0, 1), cA + hstep, voffA);
        if (wr == 1) PG8_BAR;
        PG8_WAIT_V(2); PG8_BAR;
        PG8_STAGE(PG8_SB(1, 0), cB + kstep, voffB); PG8_STAGE(PG8_SA(1, 0), cA + kstep, voffA); PG8_STAGE(PG8_SB(1, 1), cB + hstep + kstep, voffB);
        PG8_WAIT_V(6); PG8_BAR;
    } else {
        PG8_STAGE(PG8_SB(0, 0), cB, voffB); PG8_STAGE(PG8_SA(0, 0), cA, voffA); PG8_STAGE(PG8_SB(0, 1), cB + hstep, voffB); PG8_STAGE(PG8_SA(0, 1), cA + hstep, voffA);
        if (wr == 1) PG8_BAR;
        PG8_WAIT_V(4); PG8_BAR;
        PG8_STAGE(PG8_SB(1, 0), cB + kstep, voffB); PG8_STAGE(PG8_SA(1, 0), cA + kstep, voffA); PG8_STAGE(PG8_SB(1, 1), cB + hstep + kstep, voffB);
        PG8_WAIT_V(6); PG8_BAR;
    }
    for (;;) {
        const bool has_next = S.next(ui + 1, nxt);
        const char* nA = has_next ? (const char*)g.A + (size_t)nxt.pm * tstep : cA; const char* nB = has_next ? (const char*)g.Bt + (size_t)nxt.pn * tstep : cB;
        for (int t = 0; t < nt; t += 2) {
            const bool last = (t == nt - 2);
            const char* a1 = cA + (size_t)(t + 1) * kstep;
            const char* a2 = last ? nA : cA + (size_t)(t + 2) * kstep; const char* b2 = last ? nB : cB + (size_t)(t + 2) * kstep;
            const char* a3 = a2 + kstep; const char* b3 = b2 + kstep;
            if (last && has_next) S.a_ready(nxt);
            if constexpr (SP2) {
            PG8_LDB(B0, 0, 0); PG8_LDB(B1, 0, 1); PG8_SCHED; PG8_LDA(At, 0, 0); PG8_STAGE(PG8_SA(1, 1), a1 + hstep, voffA);
            PG8_WAIT_V(8); PG8_WAIT_L(0); PG8_BAR; PG8_MMA(0, 0, At, B0); PG8_MMA(0, 1, At, B1); PG8_BAR; PG8_SCHED;
            PG8_LDA(At, 0, 1); PG8_STAGE(PG8_SB(0, 0), b2, voffB); PG8_STAGE(PG8_SB(0, 1), b2 + hstep, voffB); PG8_STAGE(PG8_SA(0, 0), a2, voffA);
            PG8_WAIT_V(8); PG8_WAIT_L(0); PG8_BAR; PG8_MMA(1, 0, At, B0); PG8_MMA(1, 1, At, B1); PG8_BAR; PG8_SCHED;
            PG8_LDB(B0, 1, 0); PG8_LDB(B1, 1, 1); PG8_SCHED; PG8_LDA(At, 1, 0); PG8_STAGE(PG8_SA(0, 1), a2 + hstep, voffA);
            PG8_WAIT_V(8); PG8_WAIT_L(0); PG8_BAR; PG8_MMA(0, 0, At, B0); PG8_MMA(0, 1, At, B1); PG8_BAR; PG8_SCHED;
            PG8_LDA(At, 1, 1); PG8_STAGE(PG8_SB(1, 0), b3, voffB); PG8_STAGE(PG8_SB(1, 1), b3 + hstep, voffB); PG8_STAGE(PG8_SA(1, 0), a3, voffA);
            PG8_WAIT_V(8); PG8_WAIT_L(0); PG8_BAR; PG8_MMA(1, 0, At, B0); PG8_MMA(1, 1, At, B1); PG8_BAR; PG8_SCHED;
            } else {
            PG8_LDB(B0, 0, 0); PG8_SCHED; PG8_LDA(At, 0, 0); PG8_STAGE(PG8_SA(1, 1), a1 + hstep, voffA);
            PG8_WAIT_L(8); PG8_BAR; PG8_WAIT_L(0); PG8_MMA(0, 0, At, B0); PG8_BAR; PG8_SCHED;
            PG8_LDB(B1, 0, 1); PG8_STAGE(PG8_SB(0, 0), b2, voffB);
            PG8_BAR; PG8_WAIT_L(0); PG8_MMA(0, 1, At, B1); PG8_BAR;
            PG8_LDA(At, 0, 1); PG8_STAGE(PG8_SA(0, 0), a2, voffA);
            PG8_BAR; PG8_WAIT_L(0); PG8_MMA(1, 0, At, B0); PG8_BAR; PG8_SCHED;
            PG8_STAGE(PG8_SB(0, 1), b2 + hstep, voffB);
            PG8_WAIT_V(6); PG8_BAR; PG8_MMA(1, 1, At, B1); PG8_BAR;
            PG8_LDB(B0, 1, 0); PG8_SCHED; PG8_LDA(At, 1, 0); PG8_STAGE(PG8_SA(0, 1), a2 + hstep, voffA);
            PG8_WAIT_L(8); PG8_BAR; PG8_WAIT_L(0); PG8_MMA(0, 0, At, B0); PG8_BAR; PG8_SCHED;
            PG8_LDB(B1, 1, 1); PG8_STAGE(PG8_SB(1, 0), b3, voffB);
            PG8_BAR; PG8_WAIT_L(0); PG8_MMA(0, 1, At, B1); PG8_BAR;
            PG8_LDA(At, 1, 1); PG8_STAGE(PG8_SA(1, 0), a3, voffA);
            PG8_BAR; PG8_WAIT_L(0); PG8_MMA(1, 0, At, B0); PG8_BAR; PG8_SCHED;
            PG8_STAGE(PG8_SB(1, 1), b3 + hstep, voffB);
            PG8_WAIT_V(6); PG8_BAR; PG8_MMA(1, 1, At, B1); PG8_BAR;
            }
        }
        if constexpr (ALIGN_EPI) { if (wr == 0) PG8_BAR; }
        if constexpr (!Epi::AFTER_DRAIN) { E(acc, cur, wr, wc, fr, fq); S.done(cur); }
        if (!has_next) break;
#pragma unroll
        for (int a = 0; a < 2; ++a)
#pragma unroll
            for (int b = 0; b < 2; ++b)
#pragma unroll
                for (int m = 0; m < 4; ++m)
#pragma unroll
                    for (int n = 0; n < 2; ++n) acc[a][b][m][n] = (f32x4){0.f, 0.f, 0.f, 0.f};
        cur = nxt; cA = nA; cB = nB; ++ui;
        if constexpr (ALIGN_EPI) { if (wr == 1) PG8_BAR; }
    }
    PG8_WAIT_V(0);
    if constexpr (!ALIGN_EPI) { if (wr == 0) PG8_BAR; }
    PG8_BAR;
    if constexpr (Epi::AFTER_DRAIN) { E.fused(acc, cur, wr, wc, fr, fq, lds, wid, lane); S.done(cur); }
#undef PG8_SA
#undef PG8_SB
#undef PG8_STAGE
#undef PG8_LDA
#undef PG8_LDB
#undef PG8_MMA
#undef PG8_WAIT_V
#undef PG8_WAIT_L
#undef PG8_BAR
#undef PG8_SCHED
}
}

namespace mk {
using pg8::bf16_t; using pg8::f32x4; using pg8::u32x4; using pg8::bf16x8; using pg8::u32x2; using pg8::cvt_pk_bf16;
typedef float f32x2 __attribute__((ext_vector_type(2)));
#define LAS __attribute__((address_space(3)))

constexpr int D = 1024, DIN = 2560, DFF = 2816, NAB = 5632, DEPTH = 4, DREC = 512;
constexpr int NPROMPT = 16384, NSAMP = 512, NMETA = 16, SEQ = 2048, NB = 8, NDB = 128;
constexpr int ROW_S0 = 16384, ROW_M0 = 16896, MROWS = 16912, MP = 17152;
constexpr int NTHR = 512;
constexpr float EPS = 1e-6f;
constexpr int NCHUNK = 1024, NGITEM = 1028;

constexpr size_t O_YP = 0, O_YS = 16777216, O_PP = 17301504, O_RP = 17547264, O_CP = 19644416, O_PS = 19824640, O_RS = 23756800, O_CS = 57311232;

constexpr size_t MiB = 1u << 20;
constexpr size_t WS_WIN = 1 * MiB, WS_WOUT = 21 * MiB, WS_WAB = 29 * MiB, WS_WDN = 73 * MiB, WS_XRES = 95 * MiB, WS_XB = 162 * MiB, WS_LB = 197 * MiB,
                 WS_DV = 197 * MiB + 65536, WS_R1 = 198 * MiB, WS_Z = WS_R1, WS_Y = WS_R1 + 84 * MiB, WS_AB = WS_R1, WS_R2 = 383 * MiB, WS_H = WS_R2, WS_DS = WS_R2, WS_SST = WS_R2 + 65 * MiB, WS_END = 480 * MiB, WS_SSQ = 480 * MiB, WS_TOTAL = 491 * MiB;
static_assert(WS_WIN + (size_t)DEPTH * DIN * D * 2 <= WS_WOUT && WS_WOUT + (size_t)DEPTH * D * D * 2 <= WS_WAB && WS_WAB + (size_t)DEPTH * NAB * D * 2 <= WS_WDN && WS_WDN + (size_t)DEPTH * D * DFF * 2 <= WS_XRES, "ws map 1");
static_assert(WS_XRES + (size_t)MP * D * 4 <= WS_XB && WS_XB + (size_t)MP * D * 2 <= WS_LB && WS_SSQ + (size_t)9 * MP * 16 * 4 <= WS_TOTAL && WS_DV + (size_t)NGITEM * 128 * 4 <= WS_R1, "ws map 2");
static_assert(WS_Z + (size_t)MP * DIN * 2 <= WS_Y && WS_Y + (size_t)MP * D * 2 <= WS_R2 && WS_AB + (size_t)MP * NAB * 2 <= WS_R2 && WS_H + (size_t)MP * DFF * 2 <= WS_END && WS_DS + (size_t)NGITEM * 16384 * 4 <= WS_SST && WS_SST + (size_t)NCHUNK * 16384 * 2 <= WS_END, "ws map 3");

constexpr int RING_BYTES = 131072, MISC_OFF = RING_BYTES + 320, LDS_BYTES = 147456;
constexpr size_t WS_CTL = 0, CTL_ZERO_BYTES = 65536; constexpr int CW_BAR = 4096;
constexpr int L_QT = 0, L_KT = 17408, L_KTT = 34816, L_VT = 53248, L_AL = 71680, L_STL = 80896, L_TOT = 115712, L_EGM = 119808, L_EGL = 120320, L_SSQL = 120832;
constexpr int PQ = 136, PS = 72;

struct Params {
    const float *x_prompt, *x_sample, *state_pool, *state_rec, *state_conv, *meta, *norm1_g, *w_in, *w_pool, *pool_scale, *lb_raw, *rec_norm_g, *w_out, *norm2_g, *w_a, *w_b, *conv_w, *conv_b, *w_down, *final_g;
    float* out; unsigned char* ws;
};

__device__ __forceinline__ float bf_lo(unsigned u) { return __uint_as_float(u << 16); }
__device__ __forceinline__ float bf_hi(unsigned u) { return __uint_as_float(u & 0xffff0000u); }
__device__ __forceinline__ float bf1(bf16_t u) { return __uint_as_float((unsigned)u << 16); }
__device__ __forceinline__ float wave_sum(float v) {
#pragma unroll
    for (int o = 1; o < 64; o <<= 1) v += __shfl_xor(v, o);
    return v;
}
__device__ __forceinline__ float sigmoidf_(float x) { return 1.0f / (1.0f + __expf(-x)); }
#define LDS_WAIT() asm volatile("s_waitcnt lgkmcnt(0)" ::: "memory")
__device__ __forceinline__ int otid() { int t = threadIdx.x; asm volatile("" : "+v"(t)); return t; }

#define XB_TMO      128
#define XB_XCNT(j)  (256  + 64 * (j))
#define XB_XSUB(j)  (1280 + 64 * (j))
#define XB_XGEN(j)  (2304 + 64 * (j))
#define XB_TOP      3328
#define XB_TOPGEN   3392
#define XCD_BAR_WORDS 3456
#define XB_SPIN_CAP (1u << 18)

__device__ __forceinline__ unsigned xb_ld(unsigned* p)              { return __hip_atomic_load(p, __ATOMIC_RELAXED, __HIP_MEMORY_SCOPE_AGENT); }
__device__ __forceinline__ unsigned xb_add(unsigned* p, unsigned v) { return __hip_atomic_fetch_add(p, v, __ATOMIC_RELAXED, __HIP_MEMORY_SCOPE_AGENT); }
__device__ __forceinline__ unsigned xb_xcc_id() { return (unsigned)__builtin_amdgcn_s_getreg((3 << 11) | 20) & 0xFu; }
#define XB_SPIN(cond, bar) do { unsigned _sp = 0; while (cond) { __builtin_amdgcn_s_sleep(1); \
    if ((++_sp & 255u) == 0u) { if (xb_ld(&(bar)[XB_TMO])) break; if (_sp > XB_SPIN_CAP) { atomicAdd(&(bar)[XB_TMO], 1u); break; } } } } while (0)

struct XcdBarrier {
    unsigned* bar; unsigned x;
    volatile LAS unsigned* st;
};

__device__ __forceinline__ XcdBarrier xcd_barrier_post(unsigned* bar, volatile LAS unsigned* st) {
    XcdBarrier b; b.bar = bar; b.x = xb_xcc_id(); b.st = st;
    if (threadIdx.x == 0) (void)xb_add(&bar[XB_XCNT(b.x)], 1u);
    return b;
}
__device__ __forceinline__ void xcd_barrier_complete(unsigned* bar, unsigned x, unsigned& nloc, unsigned& nx) {
    const unsigned G = gridDim.x * gridDim.y * gridDim.z;
    unsigned sum, cnt, mine, sp = 0u;
    for (;;) {
        sum = 0u; cnt = 0u; mine = 0u;
#pragma unroll
        for (unsigned j = 0; j < 16; ++j) { const unsigned c = xb_ld(&bar[XB_XCNT(j)]); sum += c; cnt += (c > 0u) ? 1u : 0u; mine = (j == x) ? c : mine; }
        if (sum == G) break;
        __builtin_amdgcn_s_sleep(1);
        if ((++sp & 255u) == 0u) { if (xb_ld(&bar[XB_TMO])) break; if (sp > XB_SPIN_CAP) { atomicAdd(&bar[XB_TMO], 1u); break; } }
    }
    nloc = mine > 0u ? mine : 1u; nx = cnt > 0u ? cnt : 1u;
}

__device__ __forceinline__ void xcd_barrier(const XcdBarrier& b) {
    asm volatile("s_waitcnt vmcnt(0)" ::: "memory");
    __syncthreads();
    if (threadIdx.x == 0) {
        unsigned* bar = b.bar;
        __builtin_amdgcn_s_waitcnt(0);
        unsigned nloc = b.st[0], nx = b.st[1];
        if (nloc == 0u) { xcd_barrier_complete(bar, b.x, nloc, nx); b.st[0] = nloc; b.st[1] = nx; }
        const unsigned old = xb_add(&bar[XB_XSUB(b.x)], 1u);
        const unsigned gen = old / nloc;
        if (old + 1u == (gen + 1u) * nloc) {
            __builtin_amdgcn_fence(__ATOMIC_RELEASE, "agent");
            asm volatile("s_waitcnt vmcnt(0)" ::: "memory");
            const unsigned og = xb_add(&bar[XB_TOP], 1u);
            const unsigned tg = og / nx;
            if (og + 1u == (tg + 1u) * nx) xb_add(&bar[XB_TOPGEN], 1u);
            else XB_SPIN(xb_ld(&bar[XB_TOPGEN]) == tg, bar);
            __builtin_amdgcn_fence(__ATOMIC_ACQUIRE, "agent");
            xb_add(&bar[XB_XGEN(b.x)], 1u);
            asm volatile("s_waitcnt vmcnt(0)" ::: "memory");
        } else {
            XB_SPIN(xb_ld(&bar[XB_XGEN(b.x)]) == gen, bar);
            __builtin_amdgcn_fence(__ATOMIC_ACQUIRE, "agent");
            asm volatile("s_waitcnt vmcnt(0)" ::: "memory");
        }
    }
    __syncthreads();
}

__device__ __forceinline__ void tr_writeout(LAS float* scr, bf16_t* WT, int ldk, int dst_row0, int k0, int lane) {
    LDS_WAIT(); asm volatile("" ::: "memory");
    const int c = lane & 7;
#pragma unroll
    for (int j = 0; j < 4; ++j) { const int n = (lane >> 3) + 8 * j; const LAS float* s = scr + (8 * c) * 33 + n;
        u32x4 o; o.x = cvt_pk_bf16(s[0 * 33], s[1 * 33]); o.y = cvt_pk_bf16(s[2 * 33], s[3 * 33]); o.z = cvt_pk_bf16(s[4 * 33], s[5 * 33]); o.w = cvt_pk_bf16(s[6 * 33], s[7 * 33]);
        *(u32x4*)(WT + (size_t)(dst_row0 + n) * ldk + k0 + 8 * c) = o; }
    LDS_WAIT(); asm volatile("" ::: "memory");
}
__device__ __forceinline__ void tr_item(const float* W, int N, int ldk, const float* gk, bf16_t* WT, int dst_row0, LAS float* scr, int k0, int n0, int lane) {
#pragma unroll 8
    for (int i = 0; i < 32; ++i) { const int kk = 2 * i + (lane >> 5); float w = W[(size_t)(k0 + kk) * N + n0 + (lane & 31)]; if (gk) w *= gk[k0 + kk]; scr[kk * 33 + (lane & 31)] = w; }
    tr_writeout(scr, WT, ldk, dst_row0, k0, lane);
}
__device__ __forceinline__ void fold_item(const float* wp, const float* sc, const float* wout, bf16_t* WT, LAS float* scr, int k0, int n0, int lane) {
    const int g = k0 >> 7, c0 = k0 & 127, hi = lane >> 5, nl = lane & 31;
    float acc[32];
#pragma unroll
    for (int i = 0; i < 32; ++i) acc[i] = 0.f;
    for (int dch = 0; dch < 128; dch += 32) {
#pragma unroll 8
        for (int i = 0; i < 32; ++i) { const int kk = 2 * i + hi; scr[kk * 33 + nl] = wp[(size_t)(g * 128 + c0 + kk) * 128 + dch + nl]; }
        LDS_WAIT(); asm volatile("" ::: "memory");
        for (int dd = 0; dd < 32; ++dd) {
            const int dg = g * 128 + dch + dd;
            const float wv = wout[(size_t)dg * D + n0 + nl] * sc[dg];
#pragma unroll
            for (int i = 0; i < 32; ++i) acc[i] += scr[(2 * i + hi) * 33 + dd] * wv;
        }
        LDS_WAIT(); asm volatile("" ::: "memory");
    }
#pragma unroll
    for (int i = 0; i < 32; ++i) scr[(2 * i + hi) * 33 + nl] = acc[i];
    tr_writeout(scr, WT, D, n0, k0, lane);
}

__device__ __forceinline__ void prologue(const Params& p, LAS unsigned char* lds) {
    const int tid = otid(), lane = tid & 63, wave = tid >> 6;
    LAS float* scr = (LAS float*)(lds + wave * 16384);
    const int gw = blockIdx.x * 8 + wave, NGW = gridDim.x * 8;
    bf16_t* WIN = (bf16_t*)(p.ws + WS_WIN); bf16_t* WOUT = (bf16_t*)(p.ws + WS_WOUT); bf16_t* WAB = (bf16_t*)(p.ws + WS_WAB); bf16_t* WDN = (bf16_t*)(p.ws + WS_WDN);
    constexpr int I_IN = 16 * 80, I_OUT = 8 * 32, I_A = 16 * 88, I_DN = 44 * 32, PER_L = I_IN + 2 * I_OUT + 2 * I_A + I_DN;
    for (int it = gw; it < DEPTH * PER_L; it += NGW) {
        const int l = it / PER_L; int r = it % PER_L;
        if (r < I_IN) { const int kb = r / 80, nb = r % 80; tr_item(p.w_in + (size_t)l * D * DIN, DIN, D, p.norm1_g + l * D, WIN + (size_t)l * DIN * D, 32 * nb, scr, 64 * kb, 32 * nb, lane); continue; } r -= I_IN;
        if (r < I_OUT) { const int kb = 8 + r / 32, nb = r % 32; tr_item(p.w_out + (size_t)l * D * D, D, D, nullptr, WOUT + (size_t)l * D * D, 32 * nb, scr, 64 * kb, 32 * nb, lane); continue; } r -= I_OUT;
        if (r < I_OUT) { const int kb = r / 32, nb = r % 32; fold_item(p.w_pool + (size_t)l * 4 * 128 * 128, p.pool_scale + l * 512, p.w_out + (size_t)l * D * D, WOUT + (size_t)l * D * D, scr, 64 * kb, 32 * nb, lane); continue; } r -= I_OUT;
        if (r < 2 * I_A) { const int isb = r >= I_A; if (isb) r -= I_A; const int kb = r / 88, nb = r % 88, n0 = 32 * nb;
            tr_item((isb ? p.w_b : p.w_a) + (size_t)l * D * DFF, DFF, D, p.norm2_g + l * D, WAB + (size_t)l * NAB * D, (n0 >> 7) * 256 + (n0 & 127) + (isb ? 128 : 0), scr, 64 * kb, n0, lane); continue; } r -= 2 * I_A;
        { const int kb = r / 32, nb = r % 32; tr_item(p.w_down + (size_t)l * DFF * D, D, DFF, nullptr, WDN + (size_t)l * D * DFF, 32 * nb, scr, 64 * kb, 32 * nb, lane); }
    }
    float* XRES = (float*)(p.ws + WS_XRES); bf16_t* XB = (bf16_t*)(p.ws + WS_XB); float* SSQ = (float*)(p.ws + WS_SSQ);
    for (int r = gw; r < MP; r += NGW) {
        const float* src = r < ROW_S0 ? p.x_prompt + (size_t)r * D : (r < ROW_M0 ? p.x_sample + (size_t)(r - ROW_S0) * D : (r < MROWS ? p.meta + (size_t)(r - ROW_M0) * D : nullptr));
        f32x4 v[4]; float s = 0.f;
#pragma unroll
        for (int j = 0; j < 4; ++j) { v[j] = src ? *(const f32x4*)(src + 4 * lane + 256 * j) : (f32x4){0.f, 0.f, 0.f, 0.f}; s += (v[j][0] * v[j][0] + v[j][1] * v[j][1]) + (v[j][2] * v[j][2] + v[j][3] * v[j][3]); }
        s = wave_sum(s);
#pragma unroll
        for (int j = 0; j < 4; ++j) { *(f32x4*)(XRES + (size_t)r * D + 4 * lane + 256 * j) = v[j];
            u32x2 w; w.x = cvt_pk_bf16(v[j][0], v[j][1]); w.y = cvt_pk_bf16(v[j][2], v[j][3]); *(u32x2*)(XB + (size_t)r * D + 4 * lane + 256 * j) = w; }
        if (lane < 16) SSQ[(size_t)r * 16 + lane] = lane == 0 ? s : 0.f;
    }
    if (blockIdx.x == 0) {
        float* LB = (float*)(p.ws + WS_LB);
        const int j = tid; float v0 = p.lb_raw[j], v1 = p.lb_raw[512 + j], v2 = p.lb_raw[1024 + j], v3 = p.lb_raw[1536 + j];
        const float mx = fmaxf(fmaxf(v0, v1), fmaxf(v2, v3));
        const float e0 = expf(v0 - mx), e1 = expf(v1 - mx), e2 = expf(v2 - mx), e3 = expf(v3 - mx), inv = 1.0f / (e0 + e1 + e2 + e3);
        LB[j] = 0.f; LB[512 + j] = e1 * inv; LB[1024 + j] = (e1 + e2) * inv; LB[1536 + j] = (e1 + e2 + e3) * inv;
    }
}

__device__ __forceinline__ void pool_item(const Params& p, int l, int item, LAS unsigned char* lds) {
    const int tid = otid();
    const bf16_t* Z = (const bf16_t*)(p.ws + WS_Z); bf16_t* Y = (bf16_t*)(p.ws + WS_Y);
    const bool is_meta = (item == 512);
    const int t0 = is_meta ? ROW_M0 : 32 * item, nrows = is_meta ? 16 : 32;
    const bool seq_start = (!is_meta) && ((t0 & (SEQ - 1)) == 0);
    LAS bf16_t* U = (LAS bf16_t*)lds;
    for (int q = tid; q < (15 + nrows) * 64; q += NTHR) {
        const int j = q >> 6, c16 = q & 63;
        int row = t0 - 15 + j;
        if (j < 15) { if (is_meta) row = -1; else if (seq_start) row = ROW_M0 + 1 + j; }
        const u32x4 v = row >= 0 ? *(const u32x4*)(Z + (size_t)row * DIN + 8 * c16) : (u32x4){0u, 0u, 0u, 0u};
        *(LAS u32x4*)(U + j * 512 + 8 * c16) = v;
    }
    __syncthreads();
    const int cp = tid & 255, half = tid >> 8, W = 2 << (cp >> 6);
    if (16 * half < nrows) {
        float* pp = nullptr;
        if (!is_meta && half == 1 && (t0 & (SEQ - 1)) == SEQ - 32) pp = p.out + O_PP + ((size_t)(l * NB + (t0 >> 11)) * 15) * 512;
        for (int i = 0; i < 16; ++i) {
            const int e = 15 + 16 * half + i;
            float s0 = 0.f, s1 = 0.f;
            for (int j = 0; j < W; ++j) { const unsigned u = *(const LAS unsigned*)(U + (e - j) * 512 + 2 * cp); s0 += bf_lo(u); s1 += bf_hi(u); }
            const unsigned uc = *(const LAS unsigned*)(U + e * 512 + 2 * cp);
            const int cnt = is_meta ? (i + 1 < W ? i + 1 : W) : W;
            const float inv = 1.0f / (float)cnt;
            *(unsigned*)(Y + (size_t)(t0 + 16 * half + i) * D + 2 * cp) = cvt_pk_bf16(s0 * inv - bf_lo(uc), s1 * inv - bf_hi(uc));
            if (pp && i >= 1) *(f32x2*)(pp + (size_t)(i - 1) * 512 + 2 * cp) = (f32x2){bf_lo(uc), bf_hi(uc)};
        }
    }
    __syncthreads();
}
__device__ __forceinline__ void pool_sample_item(const Params& p, int l, int item) {
    const int tid = otid(), cp = tid & 255, rs = 2 * item + (tid >> 8), n = rs >> 2, t = rs & 3;
    const bf16_t* Z = (const bf16_t*)(p.ws + WS_Z); bf16_t* Y = (bf16_t*)(p.ws + WS_Y);
    const float* sp = p.state_pool + ((size_t)(l * NDB + n) * 15) * 512 + 2 * cp;
    const int W = 2 << (cp >> 6);
    float s0 = 0.f, s1 = 0.f, u0 = 0.f, u1 = 0.f;
    for (int j = 0; j < W; ++j) {
        const int e = 15 + t - j; float a0, a1;
        if (e >= 15) { const unsigned u = *(const unsigned*)(Z + (size_t)(ROW_S0 + 4 * n + (e - 15)) * DIN + 2 * cp); a0 = bf_lo(u); a1 = bf_hi(u); if (j == 0) { u0 = a0; u1 = a1; } }
        else { const f32x2 a = *(const f32x2*)(sp + (size_t)e * 512); a0 = a[0]; a1 = a[1]; }
        s0 += a0; s1 += a1;
    }
    const float inv = 1.0f / (float)W;
    *(unsigned*)(Y + (size_t)(ROW_S0 + rs) * D + 2 * cp) = cvt_pk_bf16(s0 * inv - u0, s1 * inv - u1);
    float* po = p.out + O_PS + ((size_t)(l * NDB + n) * 15) * 512 + 2 * cp;
    *(f32x2*)(po + (size_t)(11 + t) * 512) = (f32x2){u0, u1};
    for (int i = t; i < 11; i += 4) *(f32x2*)(po + (size_t)i * 512) = *(const f32x2*)(sp + (size_t)(i + 4) * 512);
}

template <bool FOR_STATE>
__device__ __forceinline__ void gla_prep(LAS unsigned char* lds, const bf16_t* Z, const float* lb, int r0, int hh, int nvalid, float* dv_out) {
    const int tid = otid(), cp = tid & 63, rg = tid >> 6, d0 = 2 * cp;
    const float lb0 = lb[d0], lb1 = lb[d0 + 1];
    unsigned qq[8], ff[8], vv[8];
#pragma unroll
    for (int i = 0; i < 8; ++i) { const bf16_t* zr = Z + (size_t)(r0 + 8 * rg + i) * DIN + hh * 128 + d0;
        qq[i] = *(const unsigned*)(zr + 512); ff[i] = *(const unsigned*)(zr + 1024); vv[i] = *(const unsigned*)(zr + 1536); }
    float g0[8], g1[8], k0[8], k1[8]; float run0 = 0.f, run1 = 0.f;
#pragma unroll
    for (int i = 0; i < 8; ++i) {
        const bool valid = (8 * rg + i) < nvalid;
        const float f0 = bf_lo(ff[i]), f1 = bf_hi(ff[i]);
        const float e0 = __expf(-f0), e1 = __expf(-f1), s0 = 1.0f / (1.0f + e0), s1 = 1.0f / (1.0f + e1);
        float lf0 = __logf(lb0 + (1.0f - lb0) * s0), lf1 = __logf(lb1 + (1.0f - lb1) * s1);
        float kk0 = (1.0f - lb0) * e0 * s0, kk1 = (1.0f - lb1) * e1 * s1;
        if (!valid) { lf0 = 0.f; lf1 = 0.f; kk0 = 0.f; kk1 = 0.f; }
        run0 += lf0; run1 += lf1; g0[i] = run0; g1[i] = run1; k0[i] = kk0; k1[i] = kk1;
    }
    LAS float* TOT = (LAS float*)(lds + L_TOT);
    *(LAS f32x2*)(TOT + rg * 128 + d0) = (f32x2){run0, run1};
    __syncthreads();
    float pre0 = 0.f, pre1 = 0.f, gm0 = 0.f, gm1 = 0.f, gl0 = 0.f, gl1 = 0.f;
#pragma unroll
    for (int g = 0; g < 8; ++g) { const f32x2 t = *(const LAS f32x2*)(TOT + g * 128 + d0);
        if (g < rg) { pre0 += t[0]; pre1 += t[1]; } if (g < 4) { gm0 += t[0]; gm1 += t[1]; } gl0 += t[0]; gl1 += t[1]; }
    LAS bf16_t* QT = (LAS bf16_t*)(lds + L_QT); LAS bf16_t* KT = (LAS bf16_t*)(lds + L_KT); LAS bf16_t* KTT = (LAS bf16_t*)(lds + L_KTT); LAS bf16_t* VT = (LAS bf16_t*)(lds + L_VT);
    float kt0[8], kt1[8];
#pragma unroll
    for (int i = 0; i < 8; ++i) {
        const float G0 = pre0 + g0[i], G1 = pre1 + g1[i];
        const float ek0 = __expf(gm0 - G0), ek1 = __expf(gm1 - G1);
        kt0[i] = k0[i] * ek0; kt1[i] = k1[i] * ek1;
        if (!FOR_STATE) {
            const float eq0 = __expf(G0 - gm0), eq1 = __expf(G1 - gm1);
            const float q0 = bf_lo(qq[i]), q1 = bf_hi(qq[i]);
            const float sq0 = q0 * sigmoidf_(q0) * 0.08838834764831845f, sq1 = q1 * sigmoidf_(q1) * 0.08838834764831845f;
            *(LAS unsigned*)(QT + (8 * rg + i) * PQ + d0) = cvt_pk_bf16(sq0 * eq0, sq1 * eq1);
            *(LAS unsigned*)(KT + (8 * rg + i) * PQ + d0) = cvt_pk_bf16(kt0[i], kt1[i]);
        }
    }
    if (FOR_STATE) {
        u32x4 w0, w1;
        w0.x = cvt_pk_bf16(kt0[0], kt0[1]); w0.y = cvt_pk_bf16(kt0[2], kt0[3]); w0.z = cvt_pk_bf16(kt0[4], kt0[5]); w0.w = cvt_pk_bf16(kt0[6], kt0[7]);
        w1.x = cvt_pk_bf16(kt1[0], kt1[1]); w1.y = cvt_pk_bf16(kt1[2], kt1[3]); w1.z = cvt_pk_bf16(kt1[4], kt1[5]); w1.w = cvt_pk_bf16(kt1[6], kt1[7]);
        *(LAS u32x4*)(KTT + d0 * PS + 8 * rg) = w0; *(LAS u32x4*)(KTT + (d0 + 1) * PS + 8 * rg) = w1;
    }
    {
        u32x4 w0, w1;
        w0.x = (vv[0] & 0xffffu) | (vv[1] << 16); w0.y = (vv[2] & 0xffffu) | (vv[3] << 16); w0.z = (vv[4] & 0xffffu) | (vv[5] << 16); w0.w = (vv[6] & 0xffffu) | (vv[7] << 16);
        w1.x = (vv[0] >> 16) | (vv[1] & 0xffff0000u); w1.y = (vv[2] >> 16) | (vv[3] & 0xffff0000u); w1.z = (vv[4] >> 16) | (vv[5] & 0xffff0000u); w1.w = (vv[6] >> 16) | (vv[7] & 0xffff0000u);
        *(LAS u32x4*)(VT + d0 * PS + 8 * rg) = w0; *(LAS u32x4*)(VT + (d0 + 1) * PS + 8 * rg) = w1;
    }
    if (rg == 0) {
        LAS float* EGM = (LAS float*)(lds + L_EGM); LAS float* EGL = (LAS float*)(lds + L_EGL);
        *(LAS f32x2*)(EGM + d0) = (f32x2){__expf(gm0), __expf(gm1)};
        *(LAS f32x2*)(EGL + d0) = (f32x2){__expf(gl0 - gm0), __expf(gl1 - gm1)};
        if (dv_out) *(f32x2*)(dv_out + d0) = (f32x2){__expf(gl0), __expf(gl1)};
    }
    __syncthreads();
}
__device__ __forceinline__ void gla_state(LAS unsigned char* lds, float* ds_out) {
    const int tid = otid(), wid = tid >> 6, lane = tid & 63, fr = lane & 15, fq = lane >> 4;
    const LAS bf16_t* KTT = (const LAS bf16_t*)(lds + L_KTT); const LAS bf16_t* VT = (const LAS bf16_t*)(lds + L_VT); const LAS float* EGL = (const LAS float*)(lds + L_EGL);
    bf16x8 a[2];
#pragma unroll
    for (int ks = 0; ks < 2; ++ks) a[ks] = *(const LAS bf16x8*)(VT + (16 * wid + fr) * PS + 32 * ks + 8 * fq);
#pragma unroll
    for (int dt = 0; dt < 8; ++dt) {
        f32x4 acc = (f32x4){0.f, 0.f, 0.f, 0.f};
#pragma unroll
        for (int ks = 0; ks < 2; ++ks) { const bf16x8 b = *(const LAS bf16x8*)(KTT + (16 * dt + fr) * PS + 32 * ks + 8 * fq); acc = __builtin_amdgcn_mfma_f32_16x16x32_bf16(a[ks], b, acc, 0, 0, 0); }
        const float egl = EGL[16 * dt + fr];
#pragma unroll
        for (int reg = 0; reg < 4; ++reg) ds_out[(size_t)(16 * wid + 4 * fq + reg) * 128 + 16 * dt + fr] = acc[reg] * egl;
    }
}
__device__ __forceinline__ void gla_out(LAS unsigned char* lds, const bf16_t* Z, const bf16_t* sst, const float* gnorm, bf16_t* Y, int r0, int hh, int nvalid) {
    const int tid = otid(), wid = tid >> 6, lane = tid & 63, fr = lane & 15, fq = lane >> 4;
    const LAS bf16_t* QT = (const LAS bf16_t*)(lds + L_QT); const LAS bf16_t* KT = (const LAS bf16_t*)(lds + L_KT); const LAS bf16_t* VT = (const LAS bf16_t*)(lds + L_VT);
    LAS bf16_t* AL = (LAS bf16_t*)(lds + L_AL); LAS bf16_t* STL = (LAS bf16_t*)(lds + L_STL); const LAS float* EGM = (const LAS float*)(lds + L_EGM); LAS float* SSQL = (LAS float*)(lds + L_SSQL);
    {
        const int v = tid >> 2, dq = (tid & 3) * 32;
#pragma unroll
        for (int j = 0; j < 4; ++j) {
            u32x4 w = (u32x4){0u, 0u, 0u, 0u};
            if (sst) { const u32x4 x = *(const u32x4*)(sst + (size_t)v * 128 + dq + 8 * j); const LAS float* e = EGM + dq + 8 * j;
                w.x = cvt_pk_bf16(bf_lo(x.x) * e[0], bf_hi(x.x) * e[1]); w.y = cvt_pk_bf16(bf_lo(x.y) * e[2], bf_hi(x.y) * e[3]);
                w.z = cvt_pk_bf16(bf_lo(x.z) * e[4], bf_hi(x.z) * e[5]); w.w = cvt_pk_bf16(bf_lo(x.w) * e[6], bf_hi(x.w) * e[7]); }
            *(LAS u32x4*)(STL + v * PQ + dq + 8 * j) = w;
        }
    }
    const int tt = wid & 3;
    {
#pragma unroll
        for (int sti = 0; sti < 2; ++sti) {
            const int st = 2 * (wid >> 2) + sti;
            f32x4 acc = (f32x4){0.f, 0.f, 0.f, 0.f};
            if (st <= tt) {
#pragma unroll
                for (int ks = 0; ks < 4; ++ks) { const bf16x8 a = *(const LAS bf16x8*)(KT + (16 * st + fr) * PQ + 32 * ks + 8 * fq), b = *(const LAS bf16x8*)(QT + (16 * tt + fr) * PQ + 32 * ks + 8 * fq);
                    acc = __builtin_amdgcn_mfma_f32_16x16x32_bf16(a, b, acc, 0, 0, 0); }
            }
            const int t = 16 * tt + fr, s0 = 16 * st + 4 * fq;
            float c[4];
#pragma unroll
            for (int reg = 0; reg < 4; ++reg) c[reg] = (st <= tt && s0 + reg <= t) ? acc[reg] : 0.f;
            u32x2 w; w.x = cvt_pk_bf16(c[0], c[1]); w.y = cvt_pk_bf16(c[2], c[3]);
            *(LAS u32x2*)(AL + t * PS + s0) = w;
        }
    }
    __syncthreads();
    const int vt0 = 4 * (wid >> 2);
    bf16x8 bA[2], bQ[4];
#pragma unroll
    for (int ks = 0; ks < 2; ++ks) bA[ks] = *(const LAS bf16x8*)(AL + (16 * tt + fr) * PS + 32 * ks + 8 * fq);
#pragma unroll
    for (int ks = 0; ks < 4; ++ks) bQ[ks] = *(const LAS bf16x8*)(QT + (16 * tt + fr) * PQ + 32 * ks + 8 * fq);
    f32x4 o[4]; float ss = 0.f;
#pragma unroll
    for (int j = 0; j < 4; ++j) {
        const int vt = vt0 + j; f32x4 acc = (f32x4){0.f, 0.f, 0.f, 0.f};
#pragma unroll
        for (int ks = 0; ks < 2; ++ks) { const bf16x8 a = *(const LAS bf16x8*)(VT + (16 * vt + fr) * PS + 32 * ks + 8 * fq); acc = __builtin_amdgcn_mfma_f32_16x16x32_bf16(a, bA[ks], acc, 0, 0, 0); }
#pragma unroll
        for (int ks = 0; ks < 4; ++ks) { const bf16x8 a = *(const LAS bf16x8*)(STL + (16 * vt + fr) * PQ + 32 * ks + 8 * fq); acc = __builtin_amdgcn_mfma_f32_16x16x32_bf16(a, bQ[ks], acc, 0, 0, 0); }
        o[j] = acc; ss += (acc[0] * acc[0] + acc[1] * acc[1]) + (acc[2] * acc[2] + acc[3] * acc[3]);
    }
    ss += __shfl_xor(ss, 16); ss += __shfl_xor(ss, 32);
    if (fq == 0) SSQL[(wid >> 2) * 64 + 16 * tt + fr] = ss;
    __syncthreads();
    const int t = 16 * tt + fr;
    const float rn = 1.0f / sqrtf((SSQL[t] + SSQL[64 + t]) * (1.0f / 128.0f) + EPS);
    if (t < nvalid) {
        const bf16_t* zg = Z + (size_t)(r0 + t) * DIN + 2048 + hh * 128; bf16_t* yo = Y + (size_t)(r0 + t) * D + 512 + hh * 128;
#pragma unroll
        for (int j = 0; j < 4; ++j) {
            const int v = 16 * (vt0 + j) + 4 * fq;
            const u32x2 gt = *(const u32x2*)(zg + v); const f32x4 gn = *(const f32x4*)(gnorm + v);
            const float g0 = bf_lo(gt.x), g1 = bf_hi(gt.x), g2 = bf_lo(gt.y), g3 = bf_hi(gt.y);
            u32x2 w; w.x = cvt_pk_bf16(o[j][0] * rn * gn[0] * g0 * sigmoidf_(g0), o[j][1] * rn * gn[1] * g1 * sigmoidf_(g1));
            w.y = cvt_pk_bf16(o[j][2] * rn * gn[2] * g2 * sigmoidf_(g2), o[j][3] * rn * gn[3] * g3 * sigmoidf_(g3));
            *(u32x2*)(yo + v) = w;
        }
    }
    __syncthreads();
}
__device__ __forceinline__ void gla_sample(LAS unsigned char* lds, const Params& p, int l, int n, int hh) {
    const int tid = otid();
    const bf16_t* Z = (const bf16_t*)(p.ws + WS_Z); bf16_t* Y = (bf16_t*)(p.ws + WS_Y);
    const float* S0 = p.state_rec + ((size_t)(l * NDB + n) * 4 + hh) * 16384; float* Sout = p.out + O_RS + ((size_t)(l * NDB + n) * 4 + hh) * 16384;
    LAS float* FG = (LAS float*)lds; LAS float* KK = FG + 512; LAS float* QS = KK + 512; LAS float* VV = QS + 512; LAS float* GT = VV + 512; LAS float* RED = GT + 512; LAS float* PART = RED + 64;
    const int r0 = ROW_S0 + 4 * n;
    {
        const int t = tid >> 7, d = tid & 127; const bf16_t* zr = Z + (size_t)(r0 + t) * DIN + hh * 128 + d;
        const float q = bf1(zr[512]), f = bf1(zr[1024]), v = bf1(zr[1536]), gt = bf1(zr[2048]);
        const float lb = ((const float*)(p.ws + WS_LB))[l * 512 + hh * 128 + d];
        const float e = __expf(-f), s = 1.0f / (1.0f + e);
        FG[tid] = lb + (1.0f - lb) * s; KK[tid] = (1.0f - lb) * e * s; QS[tid] = q * sigmoidf_(q) * 0.08838834764831845f; VV[tid] = v; GT[tid] = gt * sigmoidf_(gt);
    }
    __syncthreads();
    const int vq = tid & 31, dg = tid >> 5;
    f32x4 S[8];
#pragma unroll
    for (int i = 0; i < 8; ++i) S[i] = *(const f32x4*)(S0 + (size_t)(8 * dg + i) * 128 + 4 * vq);
#pragma unroll
    for (int t = 0; t < 4; ++t) {
        const f32x4 vv = *(const LAS f32x4*)(VV + t * 128 + 4 * vq); f32x4 po = (f32x4){0.f, 0.f, 0.f, 0.f};
#pragma unroll
        for (int i = 0; i < 8; ++i) { const int d = 8 * dg + i; S[i] = S[i] * FG[t * 128 + d] + vv * KK[t * 128 + d]; po += S[i] * QS[t * 128 + d]; }
        *(LAS f32x4*)(PART + (dg * 4 + t) * 128 + 4 * vq) = po;
    }
#pragma unroll
    for (int i = 0; i < 8; ++i) *(f32x4*)(Sout + (size_t)(8 * dg + i) * 128 + 4 * vq) = S[i];
    __syncthreads();
    {
        const int t = tid >> 7, v = tid & 127; float o = 0.f;
#pragma unroll
        for (int g = 0; g < 16; ++g) o += PART[(g * 4 + t) * 128 + v];
        const float s = wave_sum(o * o);
        if ((tid & 63) == 0) RED[tid >> 6] = s;
        __syncthreads();
        const float rn = 1.0f / sqrtf((RED[2 * t] + RED[2 * t + 1]) * (1.0f / 128.0f) + EPS);
        const float gn = p.rec_norm_g[l * 128 + v];
        const float y = o * rn * gn * GT[tid];
        Y[(size_t)(r0 + t) * D + 512 + hh * 128 + v] = (bf16_t)(cvt_pk_bf16(y, 0.f) & 0xffffu);
    }
    __syncthreads();
}
__device__ __forceinline__ void gla_scan(const Params& p, int l) {
    const float* DS = (const float*)(p.ws + WS_DS); const float* DV = (const float*)(p.ws + WS_DV); bf16_t* SST = (bf16_t*)(p.ws + WS_SST);
    for (int g = blockIdx.x * NTHR + threadIdx.x; g < 32 * 128 * 32; g += gridDim.x * NTHR) {
        const int dq = g & 31, v = (g >> 5) & 127, bh = g >> 12, hh = bh & 3;
        const size_t eo = (size_t)v * 128 + 4 * dq;
        f32x4 S = *(const f32x4*)(DS + (size_t)(NCHUNK + hh) * 16384 + eo);
#pragma unroll 4
        for (int c = 0; c < 32; ++c) {
            const int it = bh * 32 + c;
            u32x2 w; w.x = cvt_pk_bf16(S[0], S[1]); w.y = cvt_pk_bf16(S[2], S[3]);
            *(u32x2*)(SST + (size_t)it * 16384 + eo) = w;
            const f32x4 dv = *(const f32x4*)(DV + (size_t)it * 128 + 4 * dq), ds = *(const f32x4*)(DS + (size_t)it * 16384 + eo);
            S = S * dv + ds;
        }
        float* ro = p.out + O_RP + ((size_t)(l * NB + (bh >> 2)) * 4 + hh) * 16384 + v;
#pragma unroll
        for (int j = 0; j < 4; ++j) ro[(size_t)(4 * dq + j) * 128] = S[j];
    }
}

__device__ __forceinline__ f32x4 lo4(u32x4 x, int half) { return half == 0 ? (f32x4){bf_lo(x.x), bf_hi(x.x), bf_lo(x.y), bf_hi(x.y)} : (f32x4){bf_lo(x.z), bf_hi(x.z), bf_lo(x.w), bf_hi(x.w)}; }
__device__ __forceinline__ void conv_gate(const Params& p, int l) {
    const bf16_t* AB = (const bf16_t*)(p.ws + WS_AB); bf16_t* H = (bf16_t*)(p.ws + WS_H);
    const float* cw = p.conv_w + (size_t)l * 3 * DFF; const float* cb = p.conv_b + (size_t)l * DFF;
    const int total = MP * 352;
    for (int g = blockIdx.x * NTHR + threadIdx.x; g < total; g += gridDim.x * NTHR) {
        const int r = g / 352, j8 = g % 352, j = 8 * j8;
        bf16_t* ho = H + (size_t)r * DFF + j;
        if (r >= MROWS) { *(u32x4*)ho = (u32x4){0u, 0u, 0u, 0u}; continue; }
        const int acol = (j >> 7) * 256 + (j & 127);
        const u32x4 a0 = *(const u32x4*)(AB + (size_t)r * NAB + acol), bb = *(const u32x4*)(AB + (size_t)r * NAB + acol + 128);
        int t, kind;
        if (r < ROW_S0) { t = r & (SEQ - 1); kind = 0; } else if (r < ROW_M0) { t = (r - ROW_S0) & 3; kind = 1; } else { t = r - ROW_M0; kind = 2; }
        float p1[8], p2[8];
        {
            u32x4 x1 = (u32x4){0u, 0u, 0u, 0u}, x2 = (u32x4){0u, 0u, 0u, 0u}; bool f1 = false, f2 = false;
            if (t >= 1) x1 = *(const u32x4*)(AB + (size_t)(r - 1) * NAB + acol); else if (kind == 0) x1 = *(const u32x4*)(AB + (size_t)(ROW_M0 + 15) * NAB + acol); else if (kind == 1) f1 = true;
            if (t >= 2) x2 = *(const u32x4*)(AB + (size_t)(r - 2) * NAB + acol); else if (kind == 0) x2 = *(const u32x4*)(AB + (size_t)(ROW_M0 + 14 + t) * NAB + acol); else if (kind == 1) f2 = true;
            const f32x4 l1 = lo4(x1, 0), h1 = lo4(x1, 1), l2 = lo4(x2, 0), h2 = lo4(x2, 1);
#pragma unroll
            for (int e = 0; e < 4; ++e) { p1[e] = l1[e]; p1[4 + e] = h1[e]; p2[e] = l2[e]; p2[4 + e] = h2[e]; }
            if (kind == 1) {
                const int n = (r - ROW_S0) >> 2; const float* sc = p.state_conv + ((size_t)(l * NDB + n) * 2) * DFF + j;
                if (f1) { const f32x4 s0 = *(const f32x4*)(sc + DFF), s1 = *(const f32x4*)(sc + DFF + 4);
#pragma unroll
                    for (int e = 0; e < 4; ++e) { p1[e] = s0[e]; p1[4 + e] = s1[e]; } }
                if (f2) { const float* s = sc + (size_t)t * DFF; const f32x4 s0 = *(const f32x4*)s, s1 = *(const f32x4*)(s + 4);
#pragma unroll
                    for (int e = 0; e < 4; ++e) { p2[e] = s0[e]; p2[4 + e] = s1[e]; } }
            }
        }
        const f32x4 al = lo4(a0, 0), ah = lo4(a0, 1), bl = lo4(bb, 0), bh = lo4(bb, 1);
        float av[8], bv[8];
#pragma unroll
        for (int e = 0; e < 4; ++e) { av[e] = al[e]; av[4 + e] = ah[e]; bv[e] = bl[e]; bv[4 + e] = bh[e]; }
        float hv[8];
#pragma unroll
        for (int e = 0; e < 8; e += 2) {
            pg8::f32x2 ac;
            ac.x = cb[j + e] + cw[j + e] * p2[e] + cw[DFF + j + e] * p1[e] + cw[2 * DFF + j + e] * av[e];
            ac.y = cb[j + e + 1] + cw[j + e + 1] * p2[e + 1] + cw[DFF + j + e + 1] * p1[e + 1] + cw[2 * DFF + j + e + 1] * av[e + 1];
            const pg8::f32x2 ge = pg8::gelu_pk(ac);
            hv[e] = ge.x * bv[e]; hv[e + 1] = ge.y * bv[e + 1];
        }
        u32x4 w; w.x = cvt_pk_bf16(hv[0], hv[1]); w.y = cvt_pk_bf16(hv[2], hv[3]); w.z = cvt_pk_bf16(hv[4], hv[5]); w.w = cvt_pk_bf16(hv[6], hv[7]);
        *(u32x4*)ho = w;
        float* co = nullptr;
        if (kind == 0 && t >= SEQ - 2) co = p.out + O_CP + ((size_t)(l * NB + (r >> 11)) * 2 + (t - (SEQ - 2))) * DFF + j;
        if (kind == 1 && t >= 2) co = p.out + O_CS + ((size_t)(l * NDB + ((r - ROW_S0) >> 2)) * 2 + (t - 2)) * DFF + j;
        if (co) { *(f32x4*)co = (f32x4){av[0], av[1], av[2], av[3]}; *(f32x4*)(co + 4) = (f32x4){av[4], av[5], av[6], av[7]}; }
    }
}

__device__ __forceinline__ void final_norm(const Params& p) {
    const int tid = otid(), lane = tid & 63, wave = tid >> 6;
    const float* XRES = (const float*)(p.ws + WS_XRES); const float* SF = (const float*)(p.ws + WS_SSQ) + (size_t)8 * MP * 16;
    f32x4 gfin[4];
#pragma unroll
    for (int j = 0; j < 4; ++j) gfin[j] = *(const f32x4*)(p.final_g + 4 * lane + 256 * j);
    for (int r = blockIdx.x * 8 + wave; r < ROW_M0; r += gridDim.x * 8) {
        float sq = 0.f;
#pragma unroll
        for (int k = 0; k < 4; ++k) { const f32x4 q = *(const f32x4*)(SF + (size_t)r * 16 + 4 * k); sq += (q[0] + q[1]) + (q[2] + q[3]); }
        const float rs = 1.0f / sqrtf(sq * (1.0f / 1024.0f) + EPS);
        float* o = r < ROW_S0 ? p.out + O_YP + (size_t)r * D : p.out + O_YS + (size_t)(r - ROW_S0) * D;
#pragma unroll
        for (int j = 0; j < 4; ++j) { const f32x4 x = *(const f32x4*)(XRES + (size_t)r * D + 4 * lane + 256 * j); *(f32x4*)(o + 4 * lane + 256 * j) = x * rs * gfin[j]; }
    }
}

#ifndef MK_PHASE_LO
#define MK_PHASE_LO 0
#endif
__global__ void __launch_bounds__(NTHR, 2) hymba_fwd(Params p) {
    extern __shared__ __attribute__((aligned(16))) unsigned char lds_raw[];
    LAS unsigned char* lds = (LAS unsigned char*)lds_raw;
    const int G = gridDim.x, bid = blockIdx.x;
#define WSP(T, off) ((T*)(p.ws + (off)))
    if (threadIdx.x < 64) ((LAS unsigned*)(lds + MISC_OFF))[threadIdx.x] = 0u;
    __syncthreads();
    const XcdBarrier bar = xcd_barrier_post((unsigned*)(p.ws + WS_CTL) + CW_BAR, (volatile LAS unsigned*)(lds + MISC_OFF) + 8);
#define GRID_SYNC() xcd_barrier(bar)

    prologue(p, lds);
    GRID_SYNC();

    for (int l = 0; l < DEPTH; ++l) {
        {
            pg8::Gemm g{WSP(const bf16_t, WS_XB), WSP(const bf16_t, WS_WIN) + (size_t)l * DIN * D, MP, DIN, D}; pg8::StaticOrder S; S.init(MP, DIN, G, bid);
            pg8::EpiScaleBf16 E{WSP(bf16_t, WS_Z), DIN, WSP(const float, WS_SSQ) + (size_t)(2 * l) * MP * 16};
            pg8::gemm_phase<pg8::EpiScaleBf16, pg8::StaticOrder, true, true>(lds, g, S, E);
        }
        GRID_SYNC();
        {
            constexpr int N_A = NGITEM, N_B = NDB * 4, N_C = 513, N_D = 256, N_ALL = N_A + N_B + N_C + N_D + 1;
            for (int it = bid; it < N_ALL; it += G) {
                int r = it;
                if (r < N_A) {
                    const int hh = r < NCHUNK ? (r >> 5) & 3 : r - NCHUNK, r0 = r < NCHUNK ? (r >> 7) * SEQ + (r & 31) * 64 : ROW_M0, nv = r < NCHUNK ? 64 : NMETA;
                    gla_prep<true>(lds, WSP(const bf16_t, WS_Z), WSP(const float, WS_LB) + l * 512 + hh * 128, r0, hh, nv, WSP(float, WS_DV) + (size_t)r * 128);
                    gla_state(lds, WSP(float, WS_DS) + (size_t)r * 16384);
                    __syncthreads();
                    continue;
                } r -= N_A;
                if (r < N_B) { gla_sample(lds, p, l, r >> 2, r & 3); continue; } r -= N_B;
                if (r < N_C) { pool_item(p, l, r, lds); continue; } r -= N_C;
                if (r < N_D) { pool_sample_item(p, l, r); continue; } r -= N_D;
                {
                    for (int i = threadIdx.x; i < (MP - MROWS) * D / 8; i += NTHR) *(u32x4*)(WSP(bf16_t, WS_Y) + (size_t)MROWS * D + 8 * i) = (u32x4){0u, 0u, 0u, 0u};
                }
            }
        }
        GRID_SYNC();
        gla_scan(p, l);
        GRID_SYNC();
        for (int it = bid; it < NGITEM; it += G) {
            const int hh = it < NCHUNK ? (it >> 5) & 3 : it - NCHUNK, r0 = it < NCHUNK ? (it >> 7) * SEQ + (it & 31) * 64 : ROW_M0, nv = it < NCHUNK ? 64 : NMETA;
            gla_prep<false>(lds, WSP(const bf16_t, WS_Z), WSP(const float, WS_LB) + l * 512 + hh * 128, r0, hh, nv, nullptr);
            gla_out(lds, WSP(const bf16_t, WS_Z), it < NCHUNK ? WSP(const bf16_t, WS_SST) + (size_t)it * 16384 : nullptr, p.rec_norm_g + l * 128, WSP(bf16_t, WS_Y), r0, hh, nv);
        }
        GRID_SYNC();
        {
            pg8::Gemm g{WSP(const bf16_t, WS_Y), WSP(const bf16_t, WS_WOUT) + (size_t)l * D * D, MP, D, D}; pg8::StaticOrder S; S.init(MP, D, G, bid);
            pg8::EpiRes E{WSP(float, WS_XRES), WSP(bf16_t, WS_XB), WSP(float, WS_SSQ) + (size_t)(2 * l + 1) * MP * 16};
            pg8::gemm_phase<pg8::EpiRes, pg8::StaticOrder, true, true>(lds, g, S, E);
        }
        GRID_SYNC();
        {
            pg8::Gemm g{WSP(const bf16_t, WS_XB), WSP(const bf16_t, WS_WAB) + (size_t)l * NAB * D, MP, NAB, D}; pg8::StaticOrder S; S.init(MP, NAB, G, bid);
            pg8::EpiScaleBf16 E{WSP(bf16_t, WS_AB), NAB, WSP(const float, WS_SSQ) + (size_t)(2 * l + 1) * MP * 16};
            pg8::gemm_phase<pg8::EpiScaleBf16, pg8::StaticOrder, true, true>(lds, g, S, E);
        }
        GRID_SYNC();
        conv_gate(p, l);
        GRID_SYNC();
        {
            pg8::Gemm g{WSP(const bf16_t, WS_H), WSP(const bf16_t, WS_WDN) + (size_t)l * D * DFF, MP, D, DFF}; pg8::StaticOrder S; S.init(MP, D, G, bid);
            pg8::EpiRes E{WSP(float, WS_XRES), WSP(bf16_t, WS_XB), WSP(float, WS_SSQ) + (size_t)(2 * l + 2) * MP * 16};
            pg8::gemm_phase<pg8::EpiRes, pg8::StaticOrder, true, true>(lds, g, S, E);
        }
        GRID_SYNC();
    }
    final_norm(p);
}
}

extern "C" void kernel_launch(void* const* d_in, const int* in_sizes, int n_in, void* d_out, int out_size, void* d_ws, size_t ws_size, hipStream_t stream) {
    static int grid = 0;
    if (grid == 0) {
        if (n_in != 20 || ws_size < mk::WS_TOTAL) { fprintf(stderr, "kernel_launch: unexpected n_in %d / ws_size %zu\n", n_in, ws_size); grid = -1; return; }
        int dev = 0, cus = 0, per_cu = 0;
        hipGetDevice(&dev); hipDeviceGetAttribute(&cus, hipDeviceAttributeMultiprocessorCount, dev);
        hipFuncSetAttribute((const void*)mk::hymba_fwd, hipFuncAttributeMaxDynamicSharedMemorySize, mk::LDS_BYTES);
        hipOccupancyMaxActiveBlocksPerMultiprocessor(&per_cu, (const void*)mk::hymba_fwd, mk::NTHR, mk::LDS_BYTES);
        if (per_cu < 1) { fprintf(stderr, "kernel_launch: occupancy query says %d blocks per CU\n", per_cu); per_cu = 1; }
        grid = cus * 1;
    }
    if (grid < 0) return;
    mk::Params p{};
    p.x_prompt = (const float*)d_in[0]; p.x_sample = (const float*)d_in[1]; p.state_pool = (const float*)d_in[2]; p.state_rec = (const float*)d_in[3]; p.state_conv = (const float*)d_in[4];
    p.meta = (const float*)d_in[5]; p.norm1_g = (const float*)d_in[6]; p.w_in = (const float*)d_in[7]; p.w_pool = (const float*)d_in[8]; p.pool_scale = (const float*)d_in[9];
    p.lb_raw = (const float*)d_in[10]; p.rec_norm_g = (const float*)d_in[11]; p.w_out = (const float*)d_in[12]; p.norm2_g = (const float*)d_in[13]; p.w_a = (const float*)d_in[14];
    p.w_b = (const float*)d_in[15]; p.conv_w = (const float*)d_in[16]; p.conv_b = (const float*)d_in[17]; p.w_down = (const float*)d_in[18]; p.final_g = (const float*)d_in[19];
    p.out = (float*)d_out; p.ws = (unsigned char*)d_ws;
    if (hipMemsetAsync((char*)d_ws + mk::WS_CTL, 0, mk::CTL_ZERO_BYTES, stream) != hipSuccess) { fprintf(stderr, "kernel_launch: memset of the control words failed\n"); return; }
    hipLaunchKernelGGL(mk::hymba_fwd, dim3(grid), dim3(mk::NTHR), mk::LDS_BYTES, stream, p);
    const hipError_t e = hipPeekAtLastError();
    if (e != hipSuccess) fprintf(stderr, "kernel_launch: launch failed: %s (grid %d)\n", hipGetErrorString(e), grid);
}
```

```cpp
#include <hip/hip_runtime.h>
#include <cstdio>
#include <cstdint>
namespace pg8 {
#define PG8_LAS __attribute__((address_space(3)))
typedef unsigned short bf16_t;
typedef short bf16x8 __attribute__((ext_vector_type(8)));
typedef float f32x4 __attribute__((ext_vector_type(4)));
typedef unsigned u32x4 __attribute__((ext_vector_type(4)));
constexpr int BM = 256, BK = 64, HALF = 128, HTB = HALF * BK * 2  , STAGE_BYTES = 8 * HTB, NXCD = 8, WGM = 8;

__host__ __device__ __forceinline__ int lds_byte(int r, int c) { const int st = (r >> 4) * 2 + (c >> 5), rr = r & 15, cc = c & 31, ob = rr * 64 + cc * 2; return st * 1024 + (ob ^ (((ob >> 9) & 1) << 5)); }
__host__ __device__ __forceinline__ void stage_rc(int b, int& R, int& C) { const int st = b / 1024, sb = b % 1024, swz = sb ^ (((sb >> 9) & 1) << 5); R = (st >> 1) * 16 + swz / 64; C = (st & 1) * 32 + (swz % 64) / 2; }
__host__ __device__ __forceinline__ int perm32(int rho) { const int n = rho >> 4, i = rho & 15; return 8 * (i >> 2) + 4 * n + (i & 3); }

struct Unit { int pm, pn; };
struct Gemm { const bf16_t* A; const bf16_t* Bt; int M, N, K; };

struct StaticOrder {
    int nM, nN, nwg, G, c;
    __host__ __device__ void init(int M, int N, int G_, int c_) { nM = M / BM; nN = N / BM; nwg = nM * nN; G = G_; c = c_; }
    __host__ __device__ bool next(int i, Unit& u) const {
        const long L = (long)i * G + c; if (L >= nwg) return false;
        int wgid = (int)L; { const int q = nwg / NXCD, r = nwg % NXCD, xcd = wgid % NXCD, off = wgid / NXCD; wgid = (xcd < r ? xcd * (q + 1) : r * (q + 1) + (xcd - r) * q) + off; }
        const int nig = WGM * nN, gid = wgid / nig, fm = gid * WGM, gsz = (nM - fm) < WGM ? (nM - fm) : WGM;
        u.pm = fm + ((wgid % nig) % gsz); u.pn = (wgid % nig) / gsz; return true;
    }
    __device__ __forceinline__ void a_ready(const Unit&) const {}
    __device__ __forceinline__ void done(const Unit&) const {}
};

__device__ __forceinline__ unsigned cvt_pk_bf16(float lo, float hi) { unsigned r; asm volatile("v_cvt_pk_bf16_f32 %0, %1, %2" : "=v"(r) : "v"(lo), "v"(hi)); return r; }
typedef float f32x2 __attribute__((ext_vector_type(2)));
__device__ __forceinline__ f32x2 gelu_pk(f32x2 v) {
    const f32x2 av = __builtin_elementwise_abs(v), d = av * 0.2316418882f + 1.0f;
    f32x2 t; t.x = __builtin_amdgcn_rcpf(d.x); t.y = __builtin_amdgcn_rcpf(d.y);
    f32x2 q = t * 0.5307027145f + (-0.7265760135f); q = q * t + 0.7107068705f; q = q * t + (-0.142248368f); q = q * t + 0.127414796f; q = q * t;
    const f32x2 s = (v * v) * (-0.72134752044f);
    f32x2 e; e.x = __builtin_amdgcn_exp2f(s.x); e.y = __builtin_amdgcn_exp2f(s.y);
    const f32x2 m = v * (q * e), r = v - m;
    f32x2 o; o.x = v.x < 0.f ? m.x : r.x; o.y = v.y < 0.f ? m.y : r.y; return o;
}

constexpr float RMS_EPS = 1e-6f;
typedef unsigned u32x2 __attribute__((ext_vector_type(2)));

struct EpiScaleBf16 {
    static constexpr bool PERM = true, AFTER_DRAIN = false;
    bf16_t* O; int ldc; const float* ssq;
    __device__ __forceinline__ void operator()(const f32x4 (&acc)[2][2][4][2], const Unit& u, int wr, int wc, int fr, int fq) const {
        const int row0 = u.pm * BM + wr * 64 + fr, col0 = u.pn * BM + wc * 32 + 8 * fq;
#pragma unroll
        for (int ai = 0; ai < 2; ++ai)
#pragma unroll
            for (int m = 0; m < 4; ++m) {
                const int r = row0 + ai * HALF + m * 16;
                const f32x4 q0 = *(const f32x4*)(ssq + (size_t)r * 16), q1 = *(const f32x4*)(ssq + (size_t)r * 16 + 4), q2 = *(const f32x4*)(ssq + (size_t)r * 16 + 8), q3 = *(const f32x4*)(ssq + (size_t)r * 16 + 12);
                const float sq = (((q0[0] + q0[1]) + (q0[2] + q0[3])) + ((q1[0] + q1[1]) + (q1[2] + q1[3]))) + (((q2[0] + q2[1]) + (q2[2] + q2[3])) + ((q3[0] + q3[1]) + (q3[2] + q3[3])));
                const float rs = 1.0f / sqrtf(sq * (1.0f / 1024.0f) + RMS_EPS);
                bf16_t* rowp = O + (size_t)r * ldc + col0;
#pragma unroll
                for (int bj = 0; bj < 2; ++bj) {
                    const f32x4 v0 = acc[ai][bj][m][0] * rs, v1 = acc[ai][bj][m][1] * rs;
                    u32x4 w; w.x = cvt_pk_bf16(v0[0], v0[1]); w.y = cvt_pk_bf16(v0[2], v0[3]); w.z = cvt_pk_bf16(v1[0], v1[1]); w.w = cvt_pk_bf16(v1[2], v1[3]);
                    *(u32x4*)(rowp + bj * HALF) = w;
                }
            }
    }
};

struct EpiRes {
    static constexpr bool PERM = false, AFTER_DRAIN = false;
    float* X; bf16_t* XB; float* ssq;
    __device__ __forceinline__ void operator()(const f32x4 (&acc)[2][2][4][2], const Unit& u, int wr, int wc, int fr, int fq) const {
        const int col0 = u.pn * BM + wc * 32 + 4 * fq;
#pragma unroll
        for (int ai = 0; ai < 2; ++ai)
#pragma unroll
            for (int m = 0; m < 4; ++m) {
                const int r = u.pm * BM + ai * HALF + wr * 64 + m * 16 + fr;
                const size_t off = (size_t)r * 1024 + col0;
                float s = 0.f;
#pragma unroll
                for (int bj = 0; bj < 2; ++bj)
#pragma unroll
                    for (int n = 0; n < 2; ++n) {
                        float* px = X + off + bj * HALF + n * 16;
                        const f32x4 x = *(const f32x4*)px + acc[ai][bj][m][n];
                        *(f32x4*)px = x;
                        s += (x[0] * x[0] + x[1] * x[1]) + (x[2] * x[2] + x[3] * x[3]);
                        u32x2 w; w.x = cvt_pk_bf16(x[0], x[1]); w.y = cvt_pk_bf16(x[2], x[3]);
                        *(u32x2*)(XB + off + bj * HALF + n * 16) = w;
                    }
                s += __shfl_xor(s, 16); s += __shfl_xor(s, 32);
                if (fq == 0) ssq[(size_t)r * 16 + u.pn * 4 + wc] = s;
                asm volatile("" ::: "memory");
            }
    }
};

__device__ __forceinline__ float dpp_ror1(float v) { return __builtin_bit_cast(float, __builtin_amdgcn_update_dpp(0, __builtin_bit_cast(int, v), 0x121, 0xf, 0xf, false)); }
__device__ __forceinline__ float dpp_ror2(float v) { return __builtin_bit_cast(float, __builtin_amdgcn_update_dpp(0, __builtin_bit_cast(int, v), 0x122, 0xf, 0xf, false)); }
struct EpiConv {
    static constexpr bool PERM = false, AFTER_DRAIN = false;
    bf16_t* H; const float* ssq; const float* cw; const float* cb; float* tail; float* head; const float* sconv; float* out_cp; float* out_cs; PG8_LAS float* halo;
    static constexpr int FF = 2816, ROW_S0 = 16384, ROW_M0 = 16896;
    __device__ __forceinline__ float rstd(int r) const {
        const f32x4 q0 = *(const f32x4*)(ssq + (size_t)r * 16), q1 = *(const f32x4*)(ssq + (size_t)r * 16 + 4), q2 = *(const f32x4*)(ssq + (size_t)r * 16 + 8), q3 = *(const f32x4*)(ssq + (size_t)r * 16 + 12);
        const float sq = (((q0[0] + q0[1]) + (q0[2] + q0[3])) + ((q1[0] + q1[1]) + (q1[2] + q1[3]))) + (((q2[0] + q2[1]) + (q2[2] + q2[3])) + ((q3[0] + q3[1]) + (q3[2] + q3[3])));
        return 1.0f / sqrtf(sq * (1.0f / 1024.0f) + RMS_EPS);
    }
    __device__ __forceinline__ void operator()(const f32x4 (&acc)[2][2][4][2], const Unit& u, int wr, int wc, int fr, int fq) const {
        const int pm = u.pm, kind = pm < 64 ? 0 : (pm < 66 ? 1 : 2);
        const int jc = wc * 32 + 4 * fq, j0 = u.pn * 128 + jc;
        PG8_LAS float* rsL = halo + 1024;
        {
            const int tid = ((wr * 4 + wc) * 4 + fq) * 16 + fr, row = tid >> 1;
            const float* q = ssq + (size_t)(pm * BM + row) * 16 + 8 * (tid & 1);
            const f32x4 q0 = *(const f32x4*)q, q1 = *(const f32x4*)(q + 4);
            float s = ((q0[0] + q0[1]) + (q0[2] + q0[3])) + ((q1[0] + q1[1]) + (q1[2] + q1[3]));
            s += __shfl_xor(s, 1);
            if ((tid & 1) == 0) rsL[row] = 1.0f / sqrtf(s * (1.0f / 1024.0f) + RMS_EPS);
        }
        if (fr >= 14) {
#pragma unroll
            for (int n = 0; n < 2; ++n) {
                *(PG8_LAS f32x4*)(halo + ((0 * 2 + wr) * 2 + (fr - 14)) * 128 + jc + 16 * n) = acc[0][0][3][n];
                *(PG8_LAS f32x4*)(halo + ((1 * 2 + wr) * 2 + (fr - 14)) * 128 + jc + 16 * n) = acc[1][0][3][n];
            }
        }
        asm volatile("s_waitcnt lgkmcnt(0)" ::: "memory"); __builtin_amdgcn_s_barrier(); asm volatile("" ::: "memory");
        float rs[2][4];
#pragma unroll
        for (int ai = 0; ai < 2; ++ai)
#pragma unroll
            for (int m = 0; m < 4; ++m) rs[ai][m] = rsL[ai * HALF + wr * 64 + m * 16 + fr];
#pragma unroll
        for (int n = 0; n < 2; ++n) {
            const int j = j0 + 16 * n;
            const f32x4 w0 = *(const f32x4*)(cw + j), w1 = *(const f32x4*)(cw + FF + j), w2 = *(const f32x4*)(cw + 2 * FF + j), bs = *(const f32x4*)(cb + j);
#pragma unroll
            for (int ai = 0; ai < 2; ++ai) {
                const int blk = 2 * ai + wr;
                f32x4 prev = blk > 0 ? *(const PG8_LAS f32x4*)(halo + ((blk - 1) * 2 + (fr & 1)) * 128 + jc + 16 * n) * rsL[(blk - 1) * 64 + 62 + (fr & 1)] : (f32x4){0.f, 0.f, 0.f, 0.f};
#pragma unroll
                for (int m = 0; m < 4; ++m) {
                    const int r = pm * BM + ai * HALF + wr * 64 + m * 16 + fr;
                    const f32x4 cur = acc[ai][0][m][n] * rs[ai][m], bv = acc[ai][1][m][n] * rs[ai][m];
                    f32x4 p1, p2;
#pragma unroll
                    for (int e = 0; e < 4; ++e) { p1[e] = dpp_ror1(fr == 15 ? prev[e] : cur[e]); p2[e] = dpp_ror2(fr >= 14 ? prev[e] : cur[e]); }
                    if (kind == 1) {
                        const int t = fr & 3; const float* sc = sconv + (size_t)((r - ROW_S0) >> 2) * 2 * FF + j;
                        if (t == 0) { p1 = *(const f32x4*)(sc + FF); p2 = *(const f32x4*)sc; } else if (t == 1) { p2 = *(const f32x4*)(sc + FF); }
                    }
                    const f32x4 ac = bs + w0 * p2 + w1 * p1 + w2 * cur;
                    const f32x2 g0 = gelu_pk((f32x2){ac[0], ac[1]}), g1 = gelu_pk((f32x2){ac[2], ac[3]});
                    u32x2 w; w.x = cvt_pk_bf16(g0.x * bv[0], g0.y * bv[1]); w.y = cvt_pk_bf16(g1.x * bv[2], g1.y * bv[3]);
                    *(u32x2*)(H + (size_t)r * FF + j) = w;
                    if (kind == 0 && blk == 0 && m == 0 && fr < 2) {
                        float* hd = head + ((size_t)(pm * 2 + fr) * 2) * FF + j; *(f32x4*)hd = cur; *(f32x4*)(hd + FF) = bv; }
                    if (((kind != 2 && blk == 3 && m == 3) || (kind == 2 && blk == 0 && m == 0)) && fr >= 14) {
                        *(f32x4*)(tail + ((size_t)pm * 2 + (fr - 14)) * FF + j) = cur;
                        if (kind == 0 && (pm & 7) == 7) *(f32x4*)(out_cp + ((size_t)(pm >> 3) * 2 + (fr - 14)) * FF + j) = cur;
                    }
                    if (kind == 1 && (fr & 3) >= 2) *(f32x4*)(out_cs + ((size_t)((r - ROW_S0) >> 2) * 2 + ((fr & 3) - 2)) * FF + j) = cur;
                    prev = cur;
                }
            }
        }
    }
};
template <class Epi, class Sched, bool ALIGN_EPI = false, bool SP2 = false>
__device__ __forceinline__ void gemm_phase(PG8_LAS unsigned char* lds, const Gemm g, const Sched& S, const Epi& E) {
    int tid_ = threadIdx.x; asm volatile("" : "+v"(tid_));
    const int tid = tid_, wid = __builtin_amdgcn_readfirstlane(tid >> 6), lane = tid & 63, wr = wid >> 2, wc = wid & 3, fr = lane & 15, fq = lane >> 4;
    const int K = g.K, nt = K / BK;
    unsigned voffA[2], voffB[2];
#pragma unroll
    for (int i = 0; i < 2; ++i) { int R, C; stage_rc(tid * 16 + i * 8192, R, C); const int Rb = Epi::PERM ? ((R & ~31) + perm32(R & 31)) : R;
        voffA[i] = (unsigned)(R * K + C) * 2u; voffB[i] = (unsigned)(Rb * K + C) * 2u; }
    const size_t kstep = (size_t)(BK * 2);
    const size_t hstep = (size_t)HALF * K * 2;
    const size_t tstep = 2 * hstep;
    const unsigned ldsw = (unsigned)wid * 1024u;
    const int aoff = lds_byte(wr * 64 + fr, fq * 8), boff = lds_byte(wc * 32 + fr, fq * 8);
#define PG8_SA(b, h) (((b) * 2 + (h)) * HTB)
#define PG8_SB(b, h) ((4 + (b) * 2 + (h)) * HTB)
#define PG8_STAGE(bufoff, gbase, voff) do { _Pragma("unroll") for (int _i = 0; _i < 2; ++_i) \
        __builtin_amdgcn_global_load_lds((const unsigned*)((const char*)(gbase) + (voff)[_i]), (PG8_LAS unsigned*)(lds + (bufoff) + ldsw + _i * 8192), 16, 0, 0); } while (0)
#define PG8_LDA(dst, b, h) do { _Pragma("unroll") for (int m = 0; m < 4; ++m) _Pragma("unroll") for (int k = 0; k < 2; ++k) dst[m][k] = *(const PG8_LAS bf16x8*)(lds + PG8_SA(b, h) + aoff + m * 2048 + k * 1024); } while (0)
#define PG8_LDB(dst, b, h) do { _Pragma("unroll") for (int n = 0; n < 2; ++n) _Pragma("unroll") for (int k = 0; k < 2; ++k) dst[n][k] = *(const PG8_LAS bf16x8*)(lds + PG8_SB(b, h) + boff + n * 2048 + k * 1024); } while (0)
#define PG8_MMA(ai, bj, At, Bt) do { __builtin_amdgcn_s_setprio(1); _Pragma("unroll") for (int m = 0; m < 4; ++m) _Pragma("unroll") for (int n = 0; n < 2; ++n) _Pragma("unroll") for (int k = 0; k < 2; ++k) \
        acc[ai][bj][m][n] = __builtin_amdgcn_mfma_f32_16x16x32_bf16(Bt[n][k], At[m][k], acc[ai][bj][m][n], 0, 0, 0); __builtin_amdgcn_s_setprio(0); } while (0)
#define PG8_WAIT_V(n) asm volatile("s_waitcnt vmcnt(" #n ")" ::: "memory")
#define PG8_WAIT_L(n) asm volatile("s_waitcnt lgkmcnt(" #n ")" ::: "memory")
#define PG8_BAR __builtin_amdgcn_s_barrier()
#define PG8_SCHED __builtin_amdgcn_sched_barrier(0)
    Unit cur, nxt; int ui = 0;
    if (!S.next(0, cur)) return;
    f32x4 acc[2][2][4][2];
#pragma unroll
    for (int a = 0; a < 2; ++a)
#pragma unroll
        for (int b = 0; b < 2; ++b)
#pragma unroll
            for (int m = 0; m < 4; ++m)
#pragma unroll
                for (int n = 0; n < 2; ++n) acc[a][b][m][n] = (f32x4){0.f, 0.f, 0.f, 0.f};
    bf16x8 At[4][2], B0[2][2], B1[2][2];
    const char* cA = (const char*)g.A + (size_t)cur.pm * tstep; const char* cB = (const char*)g.Bt + (size_t)cur.pn * tstep;
    S.a_ready(cur);
    if constexpr (SP2) {
        PG8_STAGE(PG8_SB(0, 0), cB, voffB); PG8_STAGE(PG8_SB(0, 1), cB + hstep, voffB); PG8_STAGE(PG8_SA(0, 0), cA, voffA); PG8_STAGE(PG8_SA(0, 1), cA + hstep, voffA);
        if (wr == 1) PG8_BAR;
        PG8_WAIT_V(2); PG8_BAR;
        PG8_STAGE(PG8_SB(1, 0), cB + kstep, voffB); PG8_STAGE(PG8_SA(1, 0), cA + kstep, voffA); PG8_STAGE(PG8_SB(1, 1), cB + hstep + kstep, voffB);
        PG8_WAIT_V(6); PG8_BAR;
    } else {
        PG8_STAGE(PG8_SB(0, 0), cB, voffB); PG8_STAGE(PG8_SA(0, 0), cA, voffA); PG8_STAGE(PG8_SB(0, 1), cB + hstep, voffB); PG8_STAGE(PG8_SA(0, 1), cA + hstep, voffA);
        if (wr == 1) PG8_BAR;
        PG8_WAIT_V(4); PG8_BAR;
        PG8_STAGE(PG8_SB(1, 0), cB + kstep, voffB); PG8_STAGE(PG8_SA(1, 0), cA + kstep, voffA); PG8_STAGE(PG8_SB(1, 1), cB + hstep + kstep, voffB);
        PG8_WAIT_V(6); PG8_BAR;
    }
    for (;;) {
        const bool has_next = S.next(ui + 1, nxt);
        const char* nA = has_next ? (const char*)g.A + (size_t)nxt.pm * tstep : cA; const char* nB = has_next ? (const char*)g.Bt + (size_t)nxt.pn * tstep : cB;
        for (int t = 0; t < nt; t += 2) {
            const bool last = (t == nt - 2);
            const char* a1 = cA + (size_t)(t + 1) * kstep;
            const char* a2 = last ? nA : cA + (size_t)(t + 2) * kstep; const char* b2 = last ? nB : cB + (size_t)(t + 2) * kstep;
            const char* a3 = a2 + kstep; const char* b3 = b2 + kstep;
            if (last && has_next) S.a_ready(nxt);
            if constexpr (SP2) {
            PG8_LDB(B0, 0, 0); PG8_LDB(B1, 0, 1); PG8_SCHED; PG8_LDA(At, 0, 0); PG8_STAGE(PG8_SA(1, 1), a1 + hstep, voffA);
            PG8_WAIT_V(8); PG8_WAIT_L(0); PG8_BAR; PG8_MMA(0, 0, At, B0); PG8_MMA(0, 1, At, B1); PG8_BAR; PG8_SCHED;
            PG8_LDA(At, 0, 1); PG8_STAGE(PG8_SB(0, 0), b2, voffB); PG8_STAGE(PG8_SB(0, 1), b2 + hstep, voffB); PG8_STAGE(PG8_SA(0, 0), a2, voffA);
            PG8_WAIT_V(8); PG8_WAIT_L(0); PG8_BAR; PG8_MMA(1, 0, At, B0); PG8_MMA(1, 1, At, B1); PG8_BAR; PG8_SCHED;
            PG8_LDB(B0, 1, 0); PG8_LDB(B1, 1, 1); PG8_SCHED; PG8_LDA(At, 1, 0); PG8_STAGE(PG8_SA(0, 1), a2 + hstep, voffA);
            PG8_WAIT_V(8); PG8_WAIT_L(0); PG8_BAR; PG8_MMA(0, 0, At, B0); PG8_MMA(0, 1, At, B1); PG8_BAR; PG8_SCHED;
            PG8_LDA(At, 1, 1); PG8_STAGE(PG8_SB(1, 0), b3, voffB); PG8_STAGE(PG8_SB(1, 1), b3 + hstep, voffB); PG8_STAGE(PG8_SA(1, 0), a3, voffA);
            PG8_WAIT_V(8); PG8_WAIT_L(0); PG8_BAR; PG8_MMA(1, 0, At, B0); PG8_MMA(1, 1, At, B1); PG8_BAR; PG8_SCHED;
            } else {
            PG8_LDB(B0, 0, 0); PG8_SCHED; PG8_LDA(At, 0, 0); PG8_STAGE(PG8_SA(1, 1), a1 + hstep, voffA);
            PG8_WAIT_L(8); PG8_BAR; PG8_WAIT_L(0); PG8_MMA(0, 0, At, B0); PG8_BAR; PG8_SCHED;
            PG8_LDB(B1, 0, 1); PG8_STAGE(PG8_SB(0, 0), b2, voffB);
            PG8_BAR; PG8_WAIT_L(0); PG8_MMA(0, 1, At, B1); PG8_BAR;
            PG8_LDA(At, 0, 1); PG8_STAGE(PG8_SA(0, 0), a2, voffA);
            PG8_BAR; PG8_WAIT_L(0); PG8_MMA(1, 0, At, B0); PG8_BAR; PG8_SCHED;
            PG8_STAGE(PG8_SB(0, 1), b2 + hstep, voffB);
            PG8_WAIT_V(6); PG8_BAR; PG8_MMA(1, 1, At, B1); PG8_BAR;
            PG8_LDB(B0, 1, 0); PG8_SCHED; PG8_LDA(At, 1, 0); PG8_STAGE(PG8_SA(0, 1), a2 + hstep, voffA);
            PG8_WAIT_L(8); PG8_BAR; PG8_WAIT_L(0); PG8_MMA(0, 0, At, B0); PG8_BAR; PG8_SCHED;
            PG8_LDB(B1, 1, 1); PG8_STAGE(PG8_SB(1, 0), b3, voffB);
            PG8_BAR; PG8_WAIT_L(0); PG8_MMA(0, 1, At, B1); PG8_BAR;
            PG8_LDA(At, 1, 1); PG8_STAGE(PG8_SA(1, 0), a3, voffA);
            PG8_BAR; PG8_WAIT_L(0); PG8_MMA(1, 0, At, B0); PG8_BAR; PG8_SCHED;
            PG8_STAGE(PG8_SB(1, 1), b3 + hstep, voffB);
            PG8_WAIT_V(6); PG8_BAR; PG8_MMA(1, 1, At, B1); PG8_BAR;
            }
        }
        if constexpr (ALIGN_EPI) { if (wr == 0) PG8_BAR; }
        if constexpr (!Epi::AFTER_DRAIN) { E(acc, cur, wr, wc, fr, fq); S.done(cur); }
        if (!has_next) break;
#pragma unroll
        for (int a = 0; a < 2; ++a)
#pragma unroll
            for (int b = 0; b < 2; ++b)
#pragma unroll
                for (int m = 0; m < 4; ++m)
#pragma unroll
                    for (int n = 0; n < 2; ++n) acc[a][b][m][n] = (f32x4){0.f, 0.f, 0.f, 0.f};
        cur = nxt; cA = nA; cB = nB; ++ui;
        if constexpr (ALIGN_EPI) { if (wr == 1) PG8_BAR; }
    }
    PG8_WAIT_V(0);
    if constexpr (!ALIGN_EPI) { if (wr == 0) PG8_BAR; }
    PG8_BAR;
    if constexpr (Epi::AFTER_DRAIN) { E.fused(acc, cur, wr, wc, fr, fq, lds, wid, lane); S.done(cur); }
#undef PG8_SA
#undef PG8_SB
#undef PG8_STAGE
#undef PG8_LDA
#undef PG8_LDB
#undef PG8_MMA
#undef PG8_WAIT_V
#undef PG8_WAIT_L
#undef PG8_BAR
#undef PG8_SCHED
}
}

namespace mk {
using pg8::bf16_t; using pg8::f32x4; using pg8::u32x4; using pg8::bf16x8; using pg8::u32x2; using pg8::cvt_pk_bf16;
typedef float f32x2 __attribute__((ext_vector_type(2)));
#define LAS __attribute__((address_space(3)))

constexpr int D = 1024, DIN = 2560, DFF = 2816, NAB = 5632, DEPTH = 4, DREC = 512;
constexpr int NPROMPT = 16384, NSAMP = 512, NMETA = 16, SEQ = 2048, NB = 8, NDB = 128;
constexpr int ROW_S0 = 16384, ROW_M0 = 16896, MROWS = 16912, MP = 17152;
constexpr int NTHR = 512;
constexpr float EPS = 1e-6f;
constexpr int NCHUNK = 1024, NGITEM = 1028;

constexpr size_t O_YP = 0, O_YS = 16777216, O_PP = 17301504, O_RP = 17547264, O_CP = 19644416, O_PS = 19824640, O_RS = 23756800, O_CS = 57311232;

constexpr size_t MiB = 1u << 20;
constexpr size_t WS_WIN = 1 * MiB, WS_WOUT = 21 * MiB, WS_WAB = 29 * MiB, WS_WDN = 73 * MiB, WS_XRES = 95 * MiB, WS_XB = 162 * MiB, WS_LB = 197 * MiB, WS_DV = 197 * MiB + 65536,
                 WS_TAIL = 198 * MiB, WS_HEAD = 200 * MiB, WS_Z = 204 * MiB, WS_Y = 288 * MiB, WS_R2 = 322 * MiB, WS_H = WS_R2, WS_DS = WS_R2, WS_SST = WS_R2 + 65 * MiB, WS_SSQ = 420 * MiB, WS_TOTAL = 431 * MiB;
static_assert(WS_WIN + (size_t)DEPTH * DIN * D * 2 <= WS_WOUT && WS_WOUT + (size_t)DEPTH * D * D * 2 <= WS_WAB && WS_WAB + (size_t)DEPTH * NAB * D * 2 <= WS_WDN && WS_WDN + (size_t)DEPTH * D * DFF * 2 <= WS_XRES, "ws map 1");
static_assert(WS_XRES + (size_t)MP * D * 4 <= WS_XB && WS_XB + (size_t)MP * D * 2 <= WS_LB && WS_SSQ + (size_t)9 * MP * 16 * 4 <= WS_TOTAL && WS_DV + (size_t)NGITEM * 128 * 4 <= WS_TAIL, "ws map 2");
static_assert(WS_TAIL + (size_t)67 * 2 * DFF * 4 <= WS_HEAD && WS_HEAD + (size_t)64 * 4 * DFF * 4 <= WS_Z && WS_Z + (size_t)MP * DIN * 2 <= WS_Y && WS_Y + (size_t)MP * D * 2 <= WS_R2, "ws map 3");
static_assert(WS_H + (size_t)MP * DFF * 2 <= WS_SSQ && WS_DS + (size_t)NGITEM * 16384 * 4 <= WS_SST && WS_SST + (size_t)NCHUNK * 16384 * 2 <= WS_SSQ, "ws map 4");

constexpr int RING_BYTES = 131072, MISC_OFF = RING_BYTES + 320, HALO_OFF = RING_BYTES + 1024, LDS_BYTES = 147456;
constexpr size_t WS_CTL = 0, CTL_ZERO_BYTES = 65536; constexpr int CW_BAR = 4096;
constexpr int L_QT = 0, L_KT = 17408, L_KTT = 34816, L_VT = 53248, L_AL = 71680, L_STL = 80896, L_TOT = 115712, L_EGM = 119808, L_EGL = 120320, L_SSQL = 120832;
constexpr int PQ = 136, PS = 72;

struct Params {
    const float *x_prompt, *x_sample, *state_pool, *state_rec, *state_conv, *meta, *norm1_g, *w_in, *w_pool, *pool_scale, *lb_raw, *rec_norm_g, *w_out, *norm2_g, *w_a, *w_b, *conv_w, *conv_b, *w_down, *final_g;
    float* out; unsigned char* ws;
};

__device__ __forceinline__ float bf_lo(unsigned u) { return __uint_as_float(u << 16); }
__device__ __forceinline__ float bf_hi(unsigned u) { return __uint_as_float(u & 0xffff0000u); }
__device__ __forceinline__ float bf1(bf16_t u) { return __uint_as_float((unsigned)u << 16); }
__device__ __forceinline__ float wave_sum(float v) {
#pragma unroll
    for (int o = 1; o < 64; o <<= 1) v += __shfl_xor(v, o);
    return v;
}
__device__ __forceinline__ float sigmoidf_(float x) { return 1.0f / (1.0f + __expf(-x)); }
#define LDS_WAIT() asm volatile("s_waitcnt lgkmcnt(0)" ::: "memory")
__device__ __forceinline__ int otid() { int t = threadIdx.x; asm volatile("" : "+v"(t)); return t; }

#define XB_TMO      128
#define XB_XCNT(j)  (256  + 64 * (j))
#define XB_XSUB(j)  (1280 + 64 * (j))
#define XB_XGEN(j)  (2304 + 64 * (j))
#define XB_TOP      3328
#define XB_TOPGEN   3392
#define XCD_BAR_WORDS 3456
#define XB_SPIN_CAP (1u << 18)

__device__ __forceinline__ unsigned xb_ld(unsigned* p)              { return __hip_atomic_load(p, __ATOMIC_RELAXED, __HIP_MEMORY_SCOPE_AGENT); }
__device__ __forceinline__ unsigned xb_add(unsigned* p, unsigned v) { return __hip_atomic_fetch_add(p, v, __ATOMIC_RELAXED, __HIP_MEMORY_SCOPE_AGENT); }
__device__ __forceinline__ unsigned xb_xcc_id() { return (unsigned)__builtin_amdgcn_s_getreg((3 << 11) | 20) & 0xFu; }
#define XB_SPIN(cond, bar) do { unsigned _sp = 0; while (cond) { __builtin_amdgcn_s_sleep(1); \
    if ((++_sp & 255u) == 0u) { if (xb_ld(&(bar)[XB_TMO])) break; if (_sp > XB_SPIN_CAP) { atomicAdd(&(bar)[XB_TMO], 1u); break; } } } } while (0)

struct XcdBarrier {
    unsigned* bar; unsigned x;
    volatile LAS unsigned* st;
};

__device__ __forceinline__ XcdBarrier xcd_barrier_post(unsigned* bar, volatile LAS unsigned* st) {
    XcdBarrier b; b.bar = bar; b.x = xb_xcc_id(); b.st = st;
    if (threadIdx.x == 0) (void)xb_add(&bar[XB_XCNT(b.x)], 1u);
    return b;
}
__device__ __forceinline__ void xcd_barrier_complete(unsigned* bar, unsigned x, unsigned& nloc, unsigned& nx) {
    const unsigned G = gridDim.x * gridDim.y * gridDim.z;
    unsigned sum, cnt, mine, sp = 0u;
    for (;;) {
        sum = 0u; cnt = 0u; mine = 0u;
#pragma unroll
        for (unsigned j = 0; j < 16; ++j) { const unsigned c = xb_ld(&bar[XB_XCNT(j)]); sum += c; cnt += (c > 0u) ? 1u : 0u; mine = (j == x) ? c : mine; }
        if (sum == G) break;
        __builtin_amdgcn_s_sleep(1);
        if ((++sp & 255u) == 0u) { if (xb_ld(&bar[XB_TMO])) break; if (sp > XB_SPIN_CAP) { atomicAdd(&bar[XB_TMO], 1u); break; } }
    }
    nloc = mine > 0u ? mine : 1u; nx = cnt > 0u ? cnt : 1u;
}

__device__ __forceinline__ void xcd_barrier(const XcdBarrier& b) {
    asm volatile("s_waitcnt vmcnt(0)" ::: "memory");
    __syncthreads();
    if (threadIdx.x == 0) {
        unsigned* bar = b.bar;
        __builtin_amdgcn_s_waitcnt(0);
        unsigned nloc = b.st[0], nx = b.st[1];
        if (nloc == 0u) { xcd_barrier_complete(bar, b.x, nloc, nx); b.st[0] = nloc; b.st[1] = nx; }
        const unsigned old = xb_add(&bar[XB_XSUB(b.x)], 1u);
        const unsigned gen = old / nloc;
        if (old + 1u == (gen + 1u) * nloc) {
            __builtin_amdgcn_fence(__ATOMIC_RELEASE, "agent");
            asm volatile("s_waitcnt vmcnt(0)" ::: "memory");
            const unsigned og = xb_add(&bar[XB_TOP], 1u);
            const unsigned tg = og / nx;
            if (og + 1u == (tg + 1u) * nx) xb_add(&bar[XB_TOPGEN], 1u);
            else XB_SPIN(xb_ld(&bar[XB_TOPGEN]) == tg, bar);
            __builtin_amdgcn_fence(__ATOMIC_ACQUIRE, "agent");
            xb_add(&bar[XB_XGEN(b.x)], 1u);
            asm volatile("s_waitcnt vmcnt(0)" ::: "memory");
        } else {
            XB_SPIN(xb_ld(&bar[XB_XGEN(b.x)]) == gen, bar);
            __builtin_amdgcn_fence(__ATOMIC_ACQUIRE, "agent");
            asm volatile("s_waitcnt vmcnt(0)" ::: "memory");
        }
    }
    __syncthreads();
}

__device__ __forceinline__ void tr_item64(const float* W, int N, int ldk, const float* gk, bf16_t* WT, int dst_row, int k0, int n) {
    float w[64];
#pragma unroll
    for (int kk = 0; kk < 64; ++kk) w[kk] = W[(size_t)(k0 + kk) * N + n];
    if (gk) {
#pragma unroll
        for (int kk = 0; kk < 64; ++kk) w[kk] *= gk[k0 + kk];
    }
    bf16_t* o = WT + (size_t)dst_row * ldk + k0;
#pragma unroll
    for (int c = 0; c < 8; ++c) { u32x4 v; v.x = cvt_pk_bf16(w[8 * c], w[8 * c + 1]); v.y = cvt_pk_bf16(w[8 * c + 2], w[8 * c + 3]); v.z = cvt_pk_bf16(w[8 * c + 4], w[8 * c + 5]); v.w = cvt_pk_bf16(w[8 * c + 6], w[8 * c + 7]); *(u32x4*)(o + 8 * c) = v; }
}
__device__ __forceinline__ void fold_block(const Params& p, LAS unsigned char* lds, int l, int g, int nb) {
    const int tid = otid();
    LAS float* As = (LAS float*)lds; LAS float* Bs = As + 128 * 132;
    const float* wp = p.w_pool + ((size_t)l * 4 + g) * 16384; const float* sc = p.pool_scale + l * 512 + g * 128; const float* wo = p.w_out + (size_t)l * D * D + (size_t)(g * 128) * D + 64 * nb;
#pragma unroll
    for (int k = 0; k < 8; ++k) { const int q = tid + 512 * k, c = q >> 5, d4 = (q & 31) * 4; const f32x4 v = *(const f32x4*)(wp + c * 128 + d4) * *(const f32x4*)(sc + d4);
        As[(d4 + 0) * 132 + c] = v[0]; As[(d4 + 1) * 132 + c] = v[1]; As[(d4 + 2) * 132 + c] = v[2]; As[(d4 + 3) * 132 + c] = v[3]; }
#pragma unroll
    for (int k = 0; k < 4; ++k) { const int q = tid + 512 * k, d = q >> 4, n4 = (q & 15) * 4; *(LAS f32x4*)(Bs + d * 68 + n4) = *(const f32x4*)(wo + (size_t)d * D + n4); }
    __syncthreads();
    const int tc = tid >> 4, tn = tid & 15;
    f32x4 acc[4];
#pragma unroll
    for (int ci = 0; ci < 4; ++ci) acc[ci] = (f32x4){0.f, 0.f, 0.f, 0.f};
#pragma unroll 8
    for (int d = 0; d < 128; ++d) { const f32x4 a = *(const LAS f32x4*)(As + d * 132 + 4 * tc), b = *(const LAS f32x4*)(Bs + d * 68 + 4 * tn);
#pragma unroll
        for (int ci = 0; ci < 4; ++ci) acc[ci] += b * a[ci]; }
    bf16_t* WT = (bf16_t*)(p.ws + WS_WOUT) + (size_t)l * D * D;
#pragma unroll
    for (int nj = 0; nj < 4; ++nj) { u32x2 w; w.x = cvt_pk_bf16(acc[0][nj], acc[1][nj]); w.y = cvt_pk_bf16(acc[2][nj], acc[3][nj]);
        *(u32x2*)(WT + (size_t)(64 * nb + 4 * tn + nj) * D + g * 128 + 4 * tc) = w; }
    __syncthreads();
}

__device__ __forceinline__ void prologue(const Params& p, LAS unsigned char* lds, int parts) {
    const int tid = otid(), lane = tid & 63, wave = __builtin_amdgcn_readfirstlane(tid >> 6);
    const int gw = blockIdx.x * 8 + wave, NGW = gridDim.x * 8;
    bf16_t* WIN = (bf16_t*)(p.ws + WS_WIN); bf16_t* WOUT = (bf16_t*)(p.ws + WS_WOUT); bf16_t* WAB = (bf16_t*)(p.ws + WS_WAB); bf16_t* WDN = (bf16_t*)(p.ws + WS_WDN);
    constexpr int I_IN = 16 * 40, I_OUT = 8 * 16, I_A = 16 * 44, I_DN = 44 * 16, PER_L = I_IN + I_OUT + 2 * I_A + I_DN;
    if (parts & 1)
    for (int it = blockIdx.x; it < DEPTH * 64; it += gridDim.x) fold_block(p, lds, it >> 6, (it >> 4) & 3, it & 15);
    if (parts & 1)
    for (int it = gw; it < DEPTH * PER_L; it += NGW) {
        const int l = it / PER_L; int r = it % PER_L;
        if (r < I_IN) { const int kb = r / 40, n = 64 * (r % 40) + lane; tr_item64(p.w_in + (size_t)l * D * DIN, DIN, D, p.norm1_g + l * D, WIN + (size_t)l * DIN * D, n, 64 * kb, n); continue; } r -= I_IN;
        if (r < I_OUT) { const int kb = 8 + r / 16, n = 64 * (r % 16) + lane; tr_item64(p.w_out + (size_t)l * D * D, D, D, nullptr, WOUT + (size_t)l * D * D, n, 64 * kb, n); continue; } r -= I_OUT;
        if (r < 2 * I_A) { const int isb = r >= I_A; if (isb) r -= I_A; const int kb = r / 44, n = 64 * (r % 44) + lane;
            tr_item64((isb ? p.w_b : p.w_a) + (size_t)l * D * DFF, DFF, D, p.norm2_g + l * D, WAB + (size_t)l * NAB * D, (n >> 7) * 256 + (n & 127) + (isb ? 128 : 0), 64 * kb, n); continue; } r -= 2 * I_A;
        { const int kb = r / 16, n = 64 * (r % 16) + lane; tr_item64(p.w_down + (size_t)l * DFF * D, D, DFF, nullptr, WDN + (size_t)l * D * DFF, n, 64 * kb, n); }
    }
    float* XRES = (float*)(p.ws + WS_XRES); bf16_t* XB = (bf16_t*)(p.ws + WS_XB); float* SSQ = (float*)(p.ws + WS_SSQ);
    if (parts & 2)
    for (int r = gw; r < MP; r += NGW) {
        const float* src = r < ROW_S0 ? p.x_prompt + (size_t)r * D : (r < ROW_M0 ? p.x_sample + (size_t)(r - ROW_S0) * D : (r < MROWS ? p.meta + (size_t)(r - ROW_M0) * D : nullptr));
        f32x4 v[4]; float s = 0.f;
#pragma unroll
        for (int j = 0; j < 4; ++j) { v[j] = src ? *(const f32x4*)(src + 4 * lane + 256 * j) : (f32x4){0.f, 0.f, 0.f, 0.f}; s += (v[j][0] * v[j][0] + v[j][1] * v[j][1]) + (v[j][2] * v[j][2] + v[j][3] * v[j][3]); }
        s = wave_sum(s);
#pragma unroll
        for (int j = 0; j < 4; ++j) { *(f32x4*)(XRES + (size_t)r * D + 4 * lane + 256 * j) = v[j];
            u32x2 w; w.x = cvt_pk_bf16(v[j][0], v[j][1]); w.y = cvt_pk_bf16(v[j][2], v[j][3]); *(u32x2*)(XB + (size_t)r * D + 4 * lane + 256 * j) = w; }
        if (lane < 16) SSQ[(size_t)r * 16 + lane] = lane == 0 ? s : 0.f;
    }
    if (blockIdx.x == 0) {
        float* LB = (float*)(p.ws + WS_LB);
        const int j = tid; float v0 = p.lb_raw[j], v1 = p.lb_raw[512 + j], v2 = p.lb_raw[1024 + j], v3 = p.lb_raw[1536 + j];
        const float mx = fmaxf(fmaxf(v0, v1), fmaxf(v2, v3));
        const float e0 = expf(v0 - mx), e1 = expf(v1 - mx), e2 = expf(v2 - mx), e3 = expf(v3 - mx), inv = 1.0f / (e0 + e1 + e2 + e3);
        LB[j] = 0.f; LB[512 + j] = e1 * inv; LB[1024 + j] = (e1 + e2) * inv; LB[1536 + j] = (e1 + e2 + e3) * inv;
    }
}

__device__ __forceinline__ void pool_item(const Params& p, int l, int item, LAS unsigned char* lds) {
    const int tid = otid();
    const bf16_t* Z = (const bf16_t*)(p.ws + WS_Z); bf16_t* Y = (bf16_t*)(p.ws + WS_Y);
    const bool is_meta = (item == 512);
    const int t0 = is_meta ? ROW_M0 : 32 * item, nrows = is_meta ? 16 : 32;
    const bool seq_start = (!is_meta) && ((t0 & (SEQ - 1)) == 0);
    LAS bf16_t* U = (LAS bf16_t*)lds;
    for (int q = tid; q < (15 + nrows) * 64; q += NTHR) {
        const int j = q >> 6, c16 = q & 63;
        int row = t0 - 15 + j;
        if (j < 15) { if (is_meta) row = -1; else if (seq_start) row = ROW_M0 + 1 + j; }
        const u32x4 v = row >= 0 ? *(const u32x4*)(Z + (size_t)row * DIN + 8 * c16) : (u32x4){0u, 0u, 0u, 0u};
        *(LAS u32x4*)(U + j * 512 + 8 * c16) = v;
    }
    __syncthreads();
    const int cp = tid & 255, half = tid >> 8, W = 2 << (cp >> 6);
    if (16 * half < nrows) {
        float* pp = nullptr;
        if (!is_meta && half == 1 && (t0 & (SEQ - 1)) == SEQ - 32) pp = p.out + O_PP + ((size_t)(l * NB + (t0 >> 11)) * 15) * 512;
        for (int i = 0; i < 16; ++i) {
            const int e = 15 + 16 * half + i;
            float s0 = 0.f, s1 = 0.f;
            for (int j = 0; j < W; ++j) { const unsigned u = *(const LAS unsigned*)(U + (e - j) * 512 + 2 * cp); s0 += bf_lo(u); s1 += bf_hi(u); }
            const unsigned uc = *(const LAS unsigned*)(U + e * 512 + 2 * cp);
            const int cnt = is_meta ? (i + 1 < W ? i + 1 : W) : W;
            const float inv = 1.0f / (float)cnt;
            *(unsigned*)(Y + (size_t)(t0 + 16 * half + i) * D + 2 * cp) = cvt_pk_bf16(s0 * inv - bf_lo(uc), s1 * inv - bf_hi(uc));
            if (pp && i >= 1) *(f32x2*)(pp + (size_t)(i - 1) * 512 + 2 * cp) = (f32x2){bf_lo(uc), bf_hi(uc)};
        }
    }
    __syncthreads();
}
__device__ __forceinline__ void pool_sample_item(const Params& p, int l, int item) {
    const int tid = otid(), cp = tid & 255, rs = 2 * item + (tid >> 8), n = rs >> 2, t = rs & 3;
    const bf16_t* Z = (const bf16_t*)(p.ws + WS_Z); bf16_t* Y = (bf16_t*)(p.ws + WS_Y);
    const float* sp = p.state_pool + ((size_t)(l * NDB + n) * 15) * 512 + 2 * cp;
    const int W = 2 << (cp >> 6);
    float s0 = 0.f, s1 = 0.f, u0 = 0.f, u1 = 0.f;
    for (int j = 0; j < W; ++j) {
        const int e = 15 + t - j; float a0, a1;
        if (e >= 15) { const unsigned u = *(const unsigned*)(Z + (size_t)(ROW_S0 + 4 * n + (e - 15)) * DIN + 2 * cp); a0 = bf_lo(u); a1 = bf_hi(u); if (j == 0) { u0 = a0; u1 = a1; } }
        else { const f32x2 a = *(const f32x2*)(sp + (size_t)e * 512); a0 = a[0]; a1 = a[1]; }
        s0 += a0; s1 += a1;
    }
    const float inv = 1.0f / (float)W;
    *(unsigned*)(Y + (size_t)(ROW_S0 + rs) * D + 2 * cp) = cvt_pk_bf16(s0 * inv - u0, s1 * inv - u1);
    float* po = p.out + O_PS + ((size_t)(l * NDB + n) * 15) * 512 + 2 * cp;
    *(f32x2*)(po + (size_t)(11 + t) * 512) = (f32x2){u0, u1};
    for (int i = t; i < 11; i += 4) *(f32x2*)(po + (size_t)i * 512) = *(const f32x2*)(sp + (size_t)(i + 4) * 512);
}

template <bool FOR_STATE>
__device__ __forceinline__ void gla_prep(LAS unsigned char* lds, const bf16_t* Z, const float* lb, int r0, int hh, int nvalid, float* dv_out) {
    const int tid = otid(), cp = tid & 63, rg = tid >> 6, d0 = 2 * cp;
    const float lb0 = lb[d0], lb1 = lb[d0 + 1];
    unsigned qq[8], ff[8], vv[8];
#pragma unroll
    for (int i = 0; i < 8; ++i) { const bf16_t* zr = Z + (size_t)(r0 + 8 * rg + i) * DIN + hh * 128 + d0;
        qq[i] = *(const unsigned*)(zr + 512); ff[i] = *(const unsigned*)(zr + 1024); vv[i] = *(const unsigned*)(zr + 1536); }
    float g0[8], g1[8], k0[8], k1[8]; float run0 = 0.f, run1 = 0.f;
#pragma unroll
    for (int i = 0; i < 8; ++i) {
        const bool valid = (8 * rg + i) < nvalid;
        const float f0 = bf_lo(ff[i]), f1 = bf_hi(ff[i]);
        const float e0 = __expf(-f0), e1 = __expf(-f1), s0 = 1.0f / (1.0f + e0), s1 = 1.0f / (1.0f + e1);
        float lf0 = __logf(lb0 + (1.0f - lb0) * s0), lf1 = __logf(lb1 + (1.0f - lb1) * s1);
        float kk0 = (1.0f - lb0) * e0 * s0, kk1 = (1.0f - lb1) * e1 * s1;
        if (!valid) { lf0 = 0.f; lf1 = 0.f; kk0 = 0.f; kk1 = 0.f; }
        run0 += lf0; run1 += lf1; g0[i] = run0; g1[i] = run1; k0[i] = kk0; k1[i] = kk1;
    }
    LAS float* TOT = (LAS float*)(lds + L_TOT);
    *(LAS f32x2*)(TOT + rg * 128 + d0) = (f32x2){run0, run1};
    __syncthreads();
    float pre0 = 0.f, pre1 = 0.f, gm0 = 0.f, gm1 = 0.f, gl0 = 0.f, gl1 = 0.f;
#pragma unroll
    for (int g = 0; g < 8; ++g) { const f32x2 t = *(const LAS f32x2*)(TOT + g * 128 + d0);
        if (g < rg) { pre0 += t[0]; pre1 += t[1]; } if (g < 4) { gm0 += t[0]; gm1 += t[1]; } gl0 += t[0]; gl1 += t[1]; }
    LAS bf16_t* QT = (LAS bf16_t*)(lds + L_QT); LAS bf16_t* KT = (LAS bf16_t*)(lds + L_KT); LAS bf16_t* KTT = (LAS bf16_t*)(lds + L_KTT); LAS bf16_t* VT = (LAS bf16_t*)(lds + L_VT);
    float kt0[8], kt1[8];
#pragma unroll
    for (int i = 0; i < 8; ++i) {
        const float G0 = pre0 + g0[i], G1 = pre1 + g1[i];
        const float ek0 = __expf(gm0 - G0), ek1 = __expf(gm1 - G1);
        kt0[i] = k0[i] * ek0; kt1[i] = k1[i] * ek1;
        if (!FOR_STATE) {
            const float eq0 = __expf(G0 - gm0), eq1 = __expf(G1 - gm1);
            const float q0 = bf_lo(qq[i]), q1 = bf_hi(qq[i]);
            const float sq0 = q0 * sigmoidf_(q0) * 0.08838834764831845f, sq1 = q1 * sigmoidf_(q1) * 0.08838834764831845f;
            *(LAS unsigned*)(QT + (8 * rg + i) * PQ + d0) = cvt_pk_bf16(sq0 * eq0, sq1 * eq1);
            *(LAS unsigned*)(KT + (8 * rg + i) * PQ + d0) = cvt_pk_bf16(kt0[i], kt1[i]);
        }
    }
    if (FOR_STATE) {
        u32x4 w0, w1;
        w0.x = cvt_pk_bf16(kt0[0], kt0[1]); w0.y = cvt_pk_bf16(kt0[2], kt0[3]); w0.z = cvt_pk_bf16(kt0[4], kt0[5]); w0.w = cvt_pk_bf16(kt0[6], kt0[7]);
        w1.x = cvt_pk_bf16(kt1[0], kt1[1]); w1.y = cvt_pk_bf16(kt1[2], kt1[3]); w1.z = cvt_pk_bf16(kt1[4], kt1[5]); w1.w = cvt_pk_bf16(kt1[6], kt1[7]);
        *(LAS u32x4*)(KTT + d0 * PS + 8 * rg) = w0; *(LAS u32x4*)(KTT + (d0 + 1) * PS + 8 * rg) = w1;
    }
    {
        u32x4 w0, w1;
        w0.x = (vv[0] & 0xffffu) | (vv[1] << 16); w0.y = (vv[2] & 0xffffu) | (vv[3] << 16); w0.z = (vv[4] & 0xffffu) | (vv[5] << 16); w0.w = (vv[6] & 0xffffu) | (vv[7] << 16);
        w1.x = (vv[0] >> 16) | (vv[1] & 0xffff0000u); w1.y = (vv[2] >> 16) | (vv[3] & 0xffff0000u); w1.z = (vv[4] >> 16) | (vv[5] & 0xffff0000u); w1.w = (vv[6] >> 16) | (vv[7] & 0xffff0000u);
        *(LAS u32x4*)(VT + d0 * PS + 8 * rg) = w0; *(LAS u32x4*)(VT + (d0 + 1) * PS + 8 * rg) = w1;
    }
    if (rg == 0) {
        LAS float* EGM = (LAS float*)(lds + L_EGM); LAS float* EGL = (LAS float*)(lds + L_EGL);
        *(LAS f32x2*)(EGM + d0) = (f32x2){__expf(gm0), __expf(gm1)};
        *(LAS f32x2*)(EGL + d0) = (f32x2){__expf(gl0 - gm0), __expf(gl1 - gm1)};
        if (dv_out) *(f32x2*)(dv_out + d0) = (f32x2){__expf(gl0), __expf(gl1)};
    }
    __syncthreads();
}
__device__ __forceinline__ void gla_state(LAS unsigned char* lds, float* ds_out) {
    const int tid = otid(), wid = tid >> 6, lane = tid & 63, fr = lane & 15, fq = lane >> 4;
    const LAS bf16_t* KTT = (const LAS bf16_t*)(lds + L_KTT); const LAS bf16_t* VT = (const LAS bf16_t*)(lds + L_VT); const LAS float* EGL = (const LAS float*)(lds + L_EGL);
    bf16x8 a[2];
#pragma unroll
    for (int ks = 0; ks < 2; ++ks) a[ks] = *(const LAS bf16x8*)(VT + (16 * wid + fr) * PS + 32 * ks + 8 * fq);
#pragma unroll
    for (int dt = 0; dt < 8; ++dt) {
        f32x4 acc = (f32x4){0.f, 0.f, 0.f, 0.f};
#pragma unroll
        for (int ks = 0; ks < 2; ++ks) { const bf16x8 b = *(const LAS bf16x8*)(KTT + (16 * dt + fr) * PS + 32 * ks + 8 * fq); acc = __builtin_amdgcn_mfma_f32_16x16x32_bf16(a[ks], b, acc, 0, 0, 0); }
        const float egl = EGL[16 * dt + fr];
#pragma unroll
        for (int reg = 0; reg < 4; ++reg) ds_out[(size_t)(16 * wid + 4 * fq + reg) * 128 + 16 * dt + fr] = acc[reg] * egl;
    }
}
__device__ __forceinline__ void gla_out(LAS unsigned char* lds, const bf16_t* Z, const bf16_t* sst, const float* gnorm, bf16_t* Y, int r0, int hh, int nvalid) {
    const int tid = otid(), wid = tid >> 6, lane = tid & 63, fr = lane & 15, fq = lane >> 4;
    const LAS bf16_t* QT = (const LAS bf16_t*)(lds + L_QT); const LAS bf16_t* KT = (const LAS bf16_t*)(lds + L_KT); const LAS bf16_t* VT = (const LAS bf16_t*)(lds + L_VT);
    LAS bf16_t* AL = (LAS bf16_t*)(lds + L_AL); LAS bf16_t* STL = (LAS bf16_t*)(lds + L_STL); const LAS float* EGM = (const LAS float*)(lds + L_EGM); LAS float* SSQL = (LAS float*)(lds + L_SSQL);
    {
        const int v = tid >> 2, dq = (tid & 3) * 32;
#pragma unroll
        for (int j = 0; j < 4; ++j) {
            u32x4 w = (u32x4){0u, 0u, 0u, 0u};
            if (sst) { const u32x4 x = *(const u32x4*)(sst + (size_t)v * 128 + dq + 8 * j); const LAS float* e = EGM + dq + 8 * j;
                w.x = cvt_pk_bf16(bf_lo(x.x) * e[0], bf_hi(x.x) * e[1]); w.y = cvt_pk_bf16(bf_lo(x.y) * e[2], bf_hi(x.y) * e[3]);
                w.z = cvt_pk_bf16(bf_lo(x.z) * e[4], bf_hi(x.z) * e[5]); w.w = cvt_pk_bf16(bf_lo(x.w) * e[6], bf_hi(x.w) * e[7]); }
            *(LAS u32x4*)(STL + v * PQ + dq + 8 * j) = w;
        }
    }
    const int tt = wid & 3;
    {
#pragma unroll
        for (int sti = 0; sti < 2; ++sti) {
            const int st = 2 * (wid >> 2) + sti;
            f32x4 acc = (f32x4){0.f, 0.f, 0.f, 0.f};
            if (st <= tt) {
#pragma unroll
                for (int ks = 0; ks < 4; ++ks) { const bf16x8 a = *(const LAS bf16x8*)(KT + (16 * st + fr) * PQ + 32 * ks + 8 * fq), b = *(const LAS bf16x8*)(QT + (16 * tt + fr) * PQ + 32 * ks + 8 * fq);
                    acc = __builtin_amdgcn_mfma_f32_16x16x32_bf16(a, b, acc, 0, 0, 0); }
            }
            const int t = 16 * tt + fr, s0 = 16 * st + 4 * fq;
            float c[4];
#pragma unroll
            for (int reg = 0; reg < 4; ++reg) c[reg] = (st <= tt && s0 + reg <= t) ? acc[reg] : 0.f;
            u32x2 w; w.x = cvt_pk_bf16(c[0], c[1]); w.y = cvt_pk_bf16(c[2], c[3]);
            *(LAS u32x2*)(AL + t * PS + s0) = w;
        }
    }
    __syncthreads();
    const int vt0 = 4 * (wid >> 2);
    bf16x8 bA[2], bQ[4];
#pragma unroll
    for (int ks = 0; ks < 2; ++ks) bA[ks] = *(const LAS bf16x8*)(AL + (16 * tt + fr) * PS + 32 * ks + 8 * fq);
#pragma unroll
    for (int ks = 0; ks < 4; ++ks) bQ[ks] = *(const LAS bf16x8*)(QT + (16 * tt + fr) * PQ + 32 * ks + 8 * fq);
    f32x4 o[4]; float ss = 0.f;
#pragma unroll
    for (int j = 0; j < 4; ++j) {
        const int vt = vt0 + j; f32x4 acc = (f32x4){0.f, 0.f, 0.f, 0.f};
#pragma unroll
        for (int ks = 0; ks < 2; ++ks) { const bf16x8 a = *(const LAS bf16x8*)(VT + (16 * vt + fr) * PS + 32 * ks + 8 * fq); acc = __builtin_amdgcn_mfma_f32_16x16x32_bf16(a, bA[ks], acc, 0, 0, 0); }
#pragma unroll
        for (int ks = 0; ks < 4; ++ks) { const bf16x8 a = *(const LAS bf16x8*)(STL + (16 * vt + fr) * PQ + 32 * ks + 8 * fq); acc = __builtin_amdgcn_mfma_f32_16x16x32_bf16(a, bQ[ks], acc, 0, 0, 0); }
        o[j] = acc; ss += (acc[0] * acc[0] + acc[1] * acc[1]) + (acc[2] * acc[2] + acc[3] * acc[3]);
    }
    ss += __shfl_xor(ss, 16); ss += __shfl_xor(ss, 32);
    if (fq == 0) SSQL[(wid >> 2) * 64 + 16 * tt + fr] = ss;
    __syncthreads();
    const int t = 16 * tt + fr;
    const float rn = 1.0f / sqrtf((SSQL[t] + SSQL[64 + t]) * (1.0f / 128.0f) + EPS);
    if (t < nvalid) {
        const bf16_t* zg = Z + (size_t)(r0 + t) * DIN + 2048 + hh * 128; bf16_t* yo = Y + (size_t)(r0 + t) * D + 512 + hh * 128;
#pragma unroll
        for (int j = 0; j < 4; ++j) {
            const int v = 16 * (vt0 + j) + 4 * fq;
            const u32x2 gt = *(const u32x2*)(zg + v); const f32x4 gn = *(const f32x4*)(gnorm + v);
            const float g0 = bf_lo(gt.x), g1 = bf_hi(gt.x), g2 = bf_lo(gt.y), g3 = bf_hi(gt.y);
            u32x2 w; w.x = cvt_pk_bf16(o[j][0] * rn * gn[0] * g0 * sigmoidf_(g0), o[j][1] * rn * gn[1] * g1 * sigmoidf_(g1));
            w.y = cvt_pk_bf16(o[j][2] * rn * gn[2] * g2 * sigmoidf_(g2), o[j][3] * rn * gn[3] * g3 * sigmoidf_(g3));
            *(u32x2*)(yo + v) = w;
        }
    }
    __syncthreads();
}
__device__ __forceinline__ void gla_sample(LAS unsigned char* lds, const Params& p, int l, int n, int hh) {
    const int tid = otid();
    const bf16_t* Z = (const bf16_t*)(p.ws + WS_Z); bf16_t* Y = (bf16_t*)(p.ws + WS_Y);
    const float* S0 = p.state_rec + ((size_t)(l * NDB + n) * 4 + hh) * 16384; float* Sout = p.out + O_RS + ((size_t)(l * NDB + n) * 4 + hh) * 16384;
    LAS float* FG = (LAS float*)lds; LAS float* KK = FG + 512; LAS float* QS = KK + 512; LAS float* VV = QS + 512; LAS float* GT = VV + 512; LAS float* RED = GT + 512; LAS float* PART = RED + 64;
    const int r0 = ROW_S0 + 4 * n;
    {
        const int t = tid >> 7, d = tid & 127; const bf16_t* zr = Z + (size_t)(r0 + t) * DIN + hh * 128 + d;
        const float q = bf1(zr[512]), f = bf1(zr[1024]), v = bf1(zr[1536]), gt = bf1(zr[2048]);
        const float lb = ((const float*)(p.ws + WS_LB))[l * 512 + hh * 128 + d];
        const float e = __expf(-f), s = 1.0f / (1.0f + e);
        FG[tid] = lb + (1.0f - lb) * s; KK[tid] = (1.0f - lb) * e * s; QS[tid] = q * sigmoidf_(q) * 0.08838834764831845f; VV[tid] = v; GT[tid] = gt * sigmoidf_(gt);
    }
    __syncthreads();
    const int vq = tid & 31, dg = tid >> 5;
    f32x4 S[8];
#pragma unroll
    for (int i = 0; i < 8; ++i) S[i] = *(const f32x4*)(S0 + (size_t)(8 * dg + i) * 128 + 4 * vq);
#pragma unroll
    for (int t = 0; t < 4; ++t) {
        const f32x4 vv = *(const LAS f32x4*)(VV + t * 128 + 4 * vq); f32x4 po = (f32x4){0.f, 0.f, 0.f, 0.f};
#pragma unroll
        for (int i = 0; i < 8; ++i) { const int d = 8 * dg + i; S[i] = S[i] * FG[t * 128 + d] + vv * KK[t * 128 + d]; po += S[i] * QS[t * 128 + d]; }
        *(LAS f32x4*)(PART + (dg * 4 + t) * 128 + 4 * vq) = po;
    }
#pragma unroll
    for (int i = 0; i < 8; ++i) *(f32x4*)(Sout + (size_t)(8 * dg + i) * 128 + 4 * vq) = S[i];
    __syncthreads();
    {
        const int t = tid >> 7, v = tid & 127; float o = 0.f;
#pragma unroll
        for (int g = 0; g < 16; ++g) o += PART[(g * 4 + t) * 128 + v];
        const float s = wave_sum(o * o);
        if ((tid & 63) == 0) RED[tid >> 6] = s;
        __syncthreads();
        const float rn = 1.0f / sqrtf((RED[2 * t] + RED[2 * t + 1]) * (1.0f / 128.0f) + EPS);
        const float gn = p.rec_norm_g[l * 128 + v];
        const float y = o * rn * gn * GT[tid];
        Y[(size_t)(r0 + t) * D + 512 + hh * 128 + v] = (bf16_t)(cvt_pk_bf16(y, 0.f) & 0xffffu);
    }
    __syncthreads();
}
__device__ __forceinline__ void gla_scan(const Params& p, int l) {
    const float* DS = (const float*)(p.ws + WS_DS); const float* DV = (const float*)(p.ws + WS_DV); bf16_t* SST = (bf16_t*)(p.ws + WS_SST);
    for (int g = blockIdx.x * NTHR + otid(); g < 32 * 128 * 32; g += gridDim.x * NTHR) {
        const int dq = g & 31, v = (g >> 5) & 127, bh = g >> 12, hh = bh & 3;
        const size_t eo = (size_t)v * 128 + 4 * dq;
        f32x4 S = *(const f32x4*)(DS + (size_t)(NCHUNK + hh) * 16384 + eo);
#pragma unroll 4
        for (int c = 0; c < 32; ++c) {
            const int it = bh * 32 + c;
            u32x2 w; w.x = cvt_pk_bf16(S[0], S[1]); w.y = cvt_pk_bf16(S[2], S[3]);
            *(u32x2*)(SST + (size_t)it * 16384 + eo) = w;
            const f32x4 dv = *(const f32x4*)(DV + (size_t)it * 128 + 4 * dq), ds = *(const f32x4*)(DS + (size_t)it * 16384 + eo);
            S = S * dv + ds;
        }
        float* ro = p.out + O_RP + ((size_t)(l * NB + (bh >> 2)) * 4 + hh) * 16384 + v;
#pragma unroll
        for (int j = 0; j < 4; ++j) ro[(size_t)(4 * dq + j) * 128] = S[j];
    }
}

__device__ __forceinline__ void conv_fixup(const Params& p, int l, int pm) {
    const float* TAIL = (const float*)(p.ws + WS_TAIL); const float* HEAD = (const float*)(p.ws + WS_HEAD); bf16_t* H = (bf16_t*)(p.ws + WS_H);
    const float* cw = p.conv_w + (size_t)l * 3 * DFF; const float* cb = p.conv_b + (size_t)l * DFF;
    const int src = (pm & 7) == 0 ? 66 : pm - 1;
    const float* t0 = TAIL + (size_t)src * 2 * DFF; const float* t1 = t0 + DFF;
    const float* a0 = HEAD + (size_t)pm * 4 * DFF; const float* b0 = a0 + DFF; const float* a1 = a0 + 2 * DFF; const float* b1 = a0 + 3 * DFF;
    for (int j = 2 * otid(); j < DFF; j += 2 * NTHR) {
        const f32x2 T0 = *(const f32x2*)(t0 + j), T1 = *(const f32x2*)(t1 + j), A0 = *(const f32x2*)(a0 + j), B0 = *(const f32x2*)(b0 + j), A1 = *(const f32x2*)(a1 + j), B1 = *(const f32x2*)(b1 + j);
        const f32x2 W0 = *(const f32x2*)(cw + j), W1 = *(const f32x2*)(cw + DFF + j), W2 = *(const f32x2*)(cw + 2 * DFF + j), CB = *(const f32x2*)(cb + j);
        const pg8::f32x2 g0 = pg8::gelu_pk(CB + W0 * T0 + W1 * T1 + W2 * A0), g1 = pg8::gelu_pk(CB + W0 * T1 + W1 * A0 + W2 * A1);
        *(unsigned*)(H + (size_t)(pm * 256) * DFF + j) = cvt_pk_bf16(g0.x * B0[0], g0.y * B0[1]);
        *(unsigned*)(H + (size_t)(pm * 256 + 1) * DFF + j) = cvt_pk_bf16(g1.x * B1[0], g1.y * B1[1]);
    }
}

__device__ __forceinline__ void final_norm(const Params& p) {
    const int tid = otid(), lane = tid & 63, wave = tid >> 6;
    const float* XRES = (const float*)(p.ws + WS_XRES); const float* SF = (const float*)(p.ws + WS_SSQ) + (size_t)8 * MP * 16;
    f32x4 gfin[4];
#pragma unroll
    for (int j = 0; j < 4; ++j) gfin[j] = *(const f32x4*)(p.final_g + 4 * lane + 256 * j);
    for (int r = blockIdx.x * 8 + wave; r < ROW_M0; r += gridDim.x * 8) {
        float sq = 0.f;
#pragma unroll
        for (int k = 0; k < 4; ++k) { const f32x4 q = *(const f32x4*)(SF + (size_t)r * 16 + 4 * k); sq += (q[0] + q[1]) + (q[2] + q[3]); }
        const float rs = 1.0f / sqrtf(sq * (1.0f / 1024.0f) + EPS);
        float* o = r < ROW_S0 ? p.out + O_YP + (size_t)r * D : p.out + O_YS + (size_t)(r - ROW_S0) * D;
#pragma unroll
        for (int j = 0; j < 4; ++j) { const f32x4 x = *(const f32x4*)(XRES + (size_t)r * D + 4 * lane + 256 * j); *(f32x4*)(o + 4 * lane + 256 * j) = x * rs * gfin[j]; }
    }
}

#ifndef MK_DUP
#define MK_DUP 0
#endif
__global__ void __launch_bounds__(NTHR, 2) hymba_fwd(Params p) {
    extern __shared__ __attribute__((aligned(16))) unsigned char lds_raw[];
    LAS unsigned char* lds = (LAS unsigned char*)lds_raw;
    const int G = gridDim.x, bid = blockIdx.x;
#define WSP(T, off) ((T*)(p.ws + (off)))
    if (threadIdx.x < 64) ((LAS unsigned*)(lds + MISC_OFF))[threadIdx.x] = 0u;
    __syncthreads();
    (void)xcd_barrier_post((unsigned*)(p.ws + WS_CTL) + CW_BAR, (volatile LAS unsigned*)(lds + MISC_OFF) + 8);
#define GRID_SYNC() do { XcdBarrier b_; b_.bar = (unsigned*)(p.ws + WS_CTL) + CW_BAR; b_.x = xb_xcc_id(); b_.st = (volatile LAS unsigned*)(lds + MISC_OFF) + 8; xcd_barrier(b_); } while (0)

    prologue(p, lds, 3);
    GRID_SYNC();
#if MK_DUP == 1 || MK_DUP == 6 || MK_DUP == 7 || MK_DUP == 8
    prologue(p, lds, MK_DUP == 1 ? 3 : (MK_DUP == 6 ? 1 : (MK_DUP == 7 ? 2 : 0)));
    GRID_SYNC();
#endif

    for (int l = 0; l < DEPTH; ++l) {
        {
            pg8::Gemm g{WSP(const bf16_t, WS_XB), WSP(const bf16_t, WS_WIN) + (size_t)l * DIN * D, MP, DIN, D}; pg8::StaticOrder S; S.init(MP, DIN, G, bid);
            pg8::EpiScaleBf16 E{WSP(bf16_t, WS_Z), DIN, WSP(const float, WS_SSQ) + (size_t)(2 * l) * MP * 16};
            pg8::gemm_phase<pg8::EpiScaleBf16, pg8::StaticOrder, true, true>(lds, g, S, E);
        }
        GRID_SYNC();
        for (int rep = 0; rep < (MK_DUP == 4 ? 2 : 1); ++rep) {
            constexpr int N_A = NGITEM, N_B = NDB * 4, N_C = 513, N_D = 256, N_ALL = N_A + N_B + N_C + N_D + 1;
            for (int it = bid; it < N_ALL; it += G) {
                int r = it;
                if (r < N_A) {
                    const int hh = r < NCHUNK ? (r >> 5) & 3 : r - NCHUNK, r0 = r < NCHUNK ? (r >> 7) * SEQ + (r & 31) * 64 : ROW_M0, nv = r < NCHUNK ? 64 : NMETA;
                    gla_prep<true>(lds, WSP(const bf16_t, WS_Z), WSP(const float, WS_LB) + l * 512 + hh * 128, r0, hh, nv, WSP(float, WS_DV) + (size_t)r * 128);
                    gla_state(lds, WSP(float, WS_DS) + (size_t)r * 16384);
                    __syncthreads();
                    continue;
                } r -= N_A;
                if (r < N_B) { gla_sample(lds, p, l, r >> 2, r & 3); continue; } r -= N_B;
                if (r < N_C) { pool_item(p, l, r, lds); continue; } r -= N_C;
                if (r < N_D) { pool_sample_item(p, l, r); continue; } r -= N_D;
                {
                    for (int i = otid(); i < (MP - MROWS) * D / 8; i += NTHR) *(u32x4*)(WSP(bf16_t, WS_Y) + (size_t)MROWS * D + 8 * i) = (u32x4){0u, 0u, 0u, 0u};
                }
            }
            GRID_SYNC();
        }
        gla_scan(p, l);
        GRID_SYNC();
#if MK_DUP == 3
        gla_scan(p, l);
        GRID_SYNC();
#endif
        for (int rep = 0; rep < (MK_DUP == 5 ? 2 : 1); ++rep) {
        for (int it = bid; it < NGITEM; it += G) {
            const int hh = it < NCHUNK ? (it >> 5) & 3 : it - NCHUNK, r0 = it < NCHUNK ? (it >> 7) * SEQ + (it & 31) * 64 : ROW_M0, nv = it < NCHUNK ? 64 : NMETA;
            gla_prep<false>(lds, WSP(const bf16_t, WS_Z), WSP(const float, WS_LB) + l * 512 + hh * 128, r0, hh, nv, nullptr);
            gla_out(lds, WSP(const bf16_t, WS_Z), it < NCHUNK ? WSP(const bf16_t, WS_SST) + (size_t)it * 16384 : nullptr, p.rec_norm_g + l * 128, WSP(bf16_t, WS_Y), r0, hh, nv);
        }
        GRID_SYNC();
        }
        {
            pg8::Gemm g{WSP(const bf16_t, WS_Y), WSP(const bf16_t, WS_WOUT) + (size_t)l * D * D, MP, D, D}; pg8::StaticOrder S; S.init(MP, D, G, bid);
            pg8::EpiRes E{WSP(float, WS_XRES), WSP(bf16_t, WS_XB), WSP(float, WS_SSQ) + (size_t)(2 * l + 1) * MP * 16};
            pg8::gemm_phase<pg8::EpiRes, pg8::StaticOrder, true, true>(lds, g, S, E);
        }
        GRID_SYNC();
        {
            pg8::Gemm g{WSP(const bf16_t, WS_XB), WSP(const bf16_t, WS_WAB) + (size_t)l * NAB * D, MP, NAB, D}; pg8::StaticOrder S; S.init(MP, NAB, G, bid);
            pg8::EpiConv E{WSP(bf16_t, WS_H), WSP(const float, WS_SSQ) + (size_t)(2 * l + 1) * MP * 16, p.conv_w + (size_t)l * 3 * DFF, p.conv_b + (size_t)l * DFF, WSP(float, WS_TAIL), WSP(float, WS_HEAD),
                           p.state_conv + (size_t)l * NDB * 2 * DFF, p.out + O_CP + (size_t)l * NB * 2 * DFF, p.out + O_CS + (size_t)l * NDB * 2 * DFF, (LAS float*)(lds + HALO_OFF)};
            pg8::gemm_phase<pg8::EpiConv, pg8::StaticOrder, true, true>(lds, g, S, E);
        }
        GRID_SYNC();
        {
            pg8::Gemm g{WSP(const bf16_t, WS_H), WSP(const bf16_t, WS_WDN) + (size_t)l * D * DFF, MP, D, DFF}; pg8::StaticOrder S; S.init(MP, D, G, bid);
            { pg8::Unit uu; for (int i = 0; S.next(i, uu); ++i) if (uu.pm < 64) conv_fixup(p, l, uu.pm); }
            asm volatile("s_waitcnt vmcnt(0)" ::: "memory"); __syncthreads();
            pg8::EpiRes E{WSP(float, WS_XRES), WSP(bf16_t, WS_XB), WSP(float, WS_SSQ) + (size_t)(2 * l + 2) * MP * 16};
            pg8::gemm_phase<pg8::EpiRes, pg8::StaticOrder, true, true>(lds, g, S, E);
        }
        GRID_SYNC();
    }
    final_norm(p);
}
}

extern "C" void kernel_launch(void* const* d_in, const int* in_sizes, int n_in, void* d_out, int out_size, void* d_ws, size_t ws_size, hipStream_t stream) {
    static int grid = 0;
    if (grid == 0) {
        if (n_in != 20 || ws_size < mk::WS_TOTAL) { fprintf(stderr, "kernel_launch: unexpected n_in %d / ws_size %zu\n", n_in, ws_size); grid = -1; return; }
        int dev = 0, cus = 0, per_cu = 0;
        hipGetDevice(&dev); hipDeviceGetAttribute(&cus, hipDeviceAttributeMultiprocessorCount, dev);
        hipFuncSetAttribute((const void*)mk::hymba_fwd, hipFuncAttributeMaxDynamicSharedMemorySize, mk::LDS_BYTES);
        hipOccupancyMaxActiveBlocksPerMultiprocessor(&per_cu, (const void*)mk::hymba_fwd, mk::NTHR, mk::LDS_BYTES);
        if (per_cu < 1) { fprintf(stderr, "kernel_launch: occupancy query says %d blocks per CU\n", per_cu); per_cu = 1; }
        grid = cus * 1;
    }
    if (grid < 0) return;
    mk::Params p{};
    p.x_prompt = (const float*)d_in[0]; p.x_sample = (const float*)d_in[1]; p.state_pool = (const float*)d_in[2]; p.state_rec = (const float*)d_in[3]; p.state_conv = (const float*)d_in[4];
    p.meta = (const float*)d_in[5]; p.norm1_g = (const float*)d_in[6]; p.w_in = (const float*)d_in[7]; p.w_pool = (const float*)d_in[8]; p.pool_scale = (const float*)d_in[9];
    p.lb_raw = (const float*)d_in[10]; p.rec_norm_g = (const float*)d_in[11]; p.w_out = (const float*)d_in[12]; p.norm2_g = (const float*)d_in[13]; p.w_a = (const float*)d_in[14];
    p.w_b = (const float*)d_in[15]; p.conv_w = (const float*)d_in[16]; p.conv_b = (const float*)d_in[17]; p.w_down = (const float*)d_in[18]; p.final_g = (const float*)d_in[19];
    p.out = (float*)d_out; p.ws = (unsigned char*)d_ws;
    if (hipMemsetAsync((char*)d_ws + mk::WS_CTL, 0, mk::CTL_ZERO_BYTES, stream) != hipSuccess) { fprintf(stderr, "kernel_launch: memset of the control words failed\n"); return; }
    hipLaunchKernelGGL(mk::hymba_fwd, dim3(grid), dim3(mk::NTHR), mk::LDS_BYTES, stream, p);
    const hipError_t e = hipPeekAtLastError();
    if (e != hipSuccess) fprintf(stderr, "kernel_launch: launch failed: %s (grid %d)\n", hipGetErrorString(e), grid);
}
```

```cpp
#include <hip/hip_runtime.h>
#include <cstdio>
#include <cstdint>
namespace pg8 {
#define PG8_LAS __attribute__((address_space(3)))
typedef unsigned short bf16_t;
typedef short bf16x8 __attribute__((ext_vector_type(8)));
typedef float f32x4 __attribute__((ext_vector_type(4)));
typedef unsigned u32x4 __attribute__((ext_vector_type(4)));
constexpr int BM = 256, BK = 64, HALF = 128, HTB = HALF * BK * 2  , STAGE_BYTES = 8 * HTB, NXCD = 8, WGM = 8;

__host__ __device__ __forceinline__ int lds_byte(int r, int c) { const int st = (r >> 4) * 2 + (c >> 5), rr = r & 15, cc = c & 31, ob = rr * 64 + cc * 2; return st * 1024 + (ob ^ (((ob >> 9) & 1) << 5)); }
__host__ __device__ __forceinline__ void stage_rc(int b, int& R, int& C) { const int st = b / 1024, sb = b % 1024, swz = sb ^ (((sb >> 9) & 1) << 5); R = (st >> 1) * 16 + swz / 64; C = (st & 1) * 32 + (swz % 64) / 2; }
__host__ __device__ __forceinline__ int perm32(int rho) { const int n = rho >> 4, i = rho & 15; return 8 * (i >> 2) + 4 * n + (i & 3); }

struct Unit { int pm, pn; };
struct Gemm { const bf16_t* A; const bf16_t* Bt; int M, N, K; };

struct StaticOrder {
    int nM, nN, nwg, G, c;
    __host__ __device__ void init(int M, int N, int G_, int c_) { nM = M / BM; nN = N / BM; nwg = nM * nN; G = G_; c = c_; }
    __host__ __device__ bool next(int i, Unit& u) const {
        const long L = (long)i * G + c; if (L >= nwg) return false;
        int wgid = (int)L; { const int q = nwg / NXCD, r = nwg % NXCD, xcd = wgid % NXCD, off = wgid / NXCD; wgid = (xcd < r ? xcd * (q + 1) : r * (q + 1) + (xcd - r) * q) + off; }
        const int nig = WGM * nN, gid = wgid / nig, fm = gid * WGM, gsz = (nM - fm) < WGM ? (nM - fm) : WGM;
        u.pm = fm + ((wgid % nig) % gsz); u.pn = (wgid % nig) / gsz; return true;
    }
    __device__ __forceinline__ void a_ready(const Unit&) const {}
    __device__ __forceinline__ void done(const Unit&) const {}
};

__device__ __forceinline__ unsigned cvt_pk_bf16(float lo, float hi) { unsigned r; asm volatile("v_cvt_pk_bf16_f32 %0, %1, %2" : "=v"(r) : "v"(lo), "v"(hi)); return r; }
typedef float f32x2 __attribute__((ext_vector_type(2)));
__device__ __forceinline__ f32x2 gelu_pk(f32x2 v) {
    const f32x2 av = __builtin_elementwise_abs(v), d = av * 0.2316418882f + 1.0f;
    f32x2 t; t.x = __builtin_amdgcn_rcpf(d.x); t.y = __builtin_amdgcn_rcpf(d.y);
    f32x2 q = t * 0.5307027145f + (-0.7265760135f); q = q * t + 0.7107068705f; q = q * t + (-0.142248368f); q = q * t + 0.127414796f; q = q * t;
    const f32x2 s = (v * v) * (-0.72134752044f);
    f32x2 e; e.x = __builtin_amdgcn_exp2f(s.x); e.y = __builtin_amdgcn_exp2f(s.y);
    const f32x2 m = v * (q * e), r = v - m;
    f32x2 o; o.x = v.x < 0.f ? m.x : r.x; o.y = v.y < 0.f ? m.y : r.y; return o;
}

constexpr float RMS_EPS = 1e-6f;
typedef unsigned u32x2 __attribute__((ext_vector_type(2)));


#ifndef MK_PLAIN_ST
#define MK_PLAIN_ST 1
#endif
#ifndef MK_X_PLAIN
#define MK_X_PLAIN 0
#endif
__device__ __forceinline__ void st_wt8(void* p, unsigned lo, unsigned hi) {
#if MK_PLAIN_ST
    u32x2 w; w.x = lo; w.y = hi; *(u32x2*)p = w;
#else
    __hip_atomic_store((unsigned long long*)p, ((unsigned long long)hi << 32) | lo, __ATOMIC_RELAXED, __HIP_MEMORY_SCOPE_AGENT);
#endif
}
__device__ __forceinline__ void st_wt16(float* p, f32x4 v) {
#if MK_PLAIN_ST
    *(f32x4*)p = v;
#else
    st_wt8(p, __builtin_bit_cast(unsigned, v[0]), __builtin_bit_cast(unsigned, v[1])); st_wt8(p + 2, __builtin_bit_cast(unsigned, v[2]), __builtin_bit_cast(unsigned, v[3]));
#endif
}
__device__ __forceinline__ void st_wt4(float* p, float v) {
#if MK_PLAIN_ST
    *p = v;
#else
    __hip_atomic_store((unsigned*)p, __builtin_bit_cast(unsigned, v), __ATOMIC_RELAXED, __HIP_MEMORY_SCOPE_AGENT);
#endif
}

struct EpiScaleBf16 {
    static constexpr bool PERM = true, AFTER_DRAIN = false;
    bf16_t* O; int ldc; const float* ssq;
    __device__ __forceinline__ void operator()(const f32x4 (&acc)[2][2][4][2], const Unit& u, int wr, int wc, int fr, int fq) const {
        const int row0 = u.pm * BM + wr * 64 + fr, col0 = u.pn * BM + wc * 32 + 8 * fq;
#pragma unroll
        for (int ai = 0; ai < 2; ++ai)
#pragma unroll
            for (int m = 0; m < 4; ++m) {
                const int r = row0 + ai * HALF + m * 16;
                const f32x4 q0 = *(const f32x4*)(ssq + (size_t)r * 16), q1 = *(const f32x4*)(ssq + (size_t)r * 16 + 4), q2 = *(const f32x4*)(ssq + (size_t)r * 16 + 8), q3 = *(const f32x4*)(ssq + (size_t)r * 16 + 12);
                const float sq = (((q0[0] + q0[1]) + (q0[2] + q0[3])) + ((q1[0] + q1[1]) + (q1[2] + q1[3]))) + (((q2[0] + q2[1]) + (q2[2] + q2[3])) + ((q3[0] + q3[1]) + (q3[2] + q3[3])));
                const float rs = __builtin_amdgcn_rsqf(sq * (1.0f / 1024.0f) + RMS_EPS);
                bf16_t* rowp = O + (size_t)r * ldc + col0;
#pragma unroll
                for (int bj = 0; bj < 2; ++bj) {
                    const f32x4 v0 = acc[ai][bj][m][0] * rs, v1 = acc[ai][bj][m][1] * rs;
                    u32x4 w; w.x = cvt_pk_bf16(v0[0], v0[1]); w.y = cvt_pk_bf16(v0[2], v0[3]); w.z = cvt_pk_bf16(v1[0], v1[1]); w.w = cvt_pk_bf16(v1[2], v1[3]);
                    *(u32x4*)(rowp + bj * HALF) = w;
                }
            }
    }
};

struct EpiRes {
    static constexpr bool PERM = false, AFTER_DRAIN = false;
    float* X; bf16_t* XB; float* ssq;
    __device__ __forceinline__ void operator()(const f32x4 (&acc)[2][2][4][2], const Unit& u, int wr, int wc, int fr, int fq) const {
        const int col0 = u.pn * BM + wc * 32 + 4 * fq;
#pragma unroll
        for (int ai = 0; ai < 2; ++ai)
#pragma unroll
            for (int m = 0; m < 4; ++m) {
                const int r = u.pm * BM + ai * HALF + wr * 64 + m * 16 + fr;
                const size_t off = (size_t)r * 1024 + col0;
                float s = 0.f;
#pragma unroll
                for (int bj = 0; bj < 2; ++bj)
#pragma unroll
                    for (int n = 0; n < 2; ++n) {
                        float* px = X + off + bj * HALF + n * 16;
                        const f32x4 x = *(const f32x4*)px + acc[ai][bj][m][n];
#if MK_X_PLAIN == 1
                        *(f32x4*)px = x;
#elif MK_X_PLAIN == 2
                        asm volatile("global_store_dwordx4 %0, %1, off sc1\n\ts_nop 1" :: "v"(px), "v"(x) : "memory");
#else
                        st_wt16(px, x);
#endif
                        s += (x[0] * x[0] + x[1] * x[1]) + (x[2] * x[2] + x[3] * x[3]);
                        st_wt8(XB + off + bj * HALF + n * 16, cvt_pk_bf16(x[0], x[1]), cvt_pk_bf16(x[2], x[3]));
                    }
                s += __shfl_xor(s, 16); s += __shfl_xor(s, 32);
                if (fq == 0) st_wt4(ssq + (size_t)r * 16 + u.pn * 4 + wc, s);
                asm volatile("" ::: "memory");
            }
    }
};

__device__ __forceinline__ float dpp_ror1(float v) { return __builtin_bit_cast(float, __builtin_amdgcn_update_dpp(0, __builtin_bit_cast(int, v), 0x121, 0xf, 0xf, false)); }
__device__ __forceinline__ float dpp_ror2(float v) { return __builtin_bit_cast(float, __builtin_amdgcn_update_dpp(0, __builtin_bit_cast(int, v), 0x122, 0xf, 0xf, false)); }
struct EpiConv {
    static constexpr bool PERM = false, AFTER_DRAIN = false;
    bf16_t* H; const float* ssq; const float* cw; const float* cb; float* tail; float* head; const float* sconv; float* out_cp; float* out_cs; PG8_LAS float* halo;
    static constexpr int FF = 2816, ROW_S0 = 16384, ROW_M0 = 16896;
    __device__ __forceinline__ float rstd(int r) const {
        const f32x4 q0 = *(const f32x4*)(ssq + (size_t)r * 16), q1 = *(const f32x4*)(ssq + (size_t)r * 16 + 4), q2 = *(const f32x4*)(ssq + (size_t)r * 16 + 8), q3 = *(const f32x4*)(ssq + (size_t)r * 16 + 12);
        const float sq = (((q0[0] + q0[1]) + (q0[2] + q0[3])) + ((q1[0] + q1[1]) + (q1[2] + q1[3]))) + (((q2[0] + q2[1]) + (q2[2] + q2[3])) + ((q3[0] + q3[1]) + (q3[2] + q3[3])));
        return __builtin_amdgcn_rsqf(sq * (1.0f / 1024.0f) + RMS_EPS);
    }
    __device__ __forceinline__ void operator()(const f32x4 (&acc)[2][2][4][2], const Unit& u, int wr, int wc, int fr, int fq) const {
        const int pm = u.pm, kind = pm < 64 ? 0 : (pm < 66 ? 1 : 2);
        const int jc = wc * 32 + 4 * fq, j0 = u.pn * 128 + jc;
        PG8_LAS float* rsL = halo + 1024;
        {
            const int tid = ((wr * 4 + wc) * 4 + fq) * 16 + fr, row = tid >> 1;
            const float* q = ssq + (size_t)(pm * BM + row) * 16 + 8 * (tid & 1);
            const f32x4 q0 = *(const f32x4*)q, q1 = *(const f32x4*)(q + 4);
            float s = ((q0[0] + q0[1]) + (q0[2] + q0[3])) + ((q1[0] + q1[1]) + (q1[2] + q1[3]));
            s += __shfl_xor(s, 1);
            if ((tid & 1) == 0) rsL[row] = __builtin_amdgcn_rsqf(s * (1.0f / 1024.0f) + RMS_EPS);
        }
        if (fr >= 14) {
#pragma unroll
            for (int n = 0; n < 2; ++n) {
                *(PG8_LAS f32x4*)(halo + ((0 * 2 + wr) * 2 + (fr - 14)) * 128 + jc + 16 * n) = acc[0][0][3][n];
                *(PG8_LAS f32x4*)(halo + ((1 * 2 + wr) * 2 + (fr - 14)) * 128 + jc + 16 * n) = acc[1][0][3][n];
            }
        }
        asm volatile("s_waitcnt lgkmcnt(0)" ::: "memory"); __builtin_amdgcn_s_barrier(); asm volatile("" ::: "memory");
#pragma unroll
        for (int n = 0; n < 2; ++n) {
            const int j = j0 + 16 * n;
            const f32x4 w0 = *(const f32x4*)(cw + j), w1 = *(const f32x4*)(cw + FF + j), w2 = *(const f32x4*)(cw + 2 * FF + j), bs = *(const f32x4*)(cb + j);
#pragma unroll
            for (int ai = 0; ai < 2; ++ai) {
                const int blk = 2 * ai + wr;
                f32x4 prev = blk > 0 ? *(const PG8_LAS f32x4*)(halo + ((blk - 1) * 2 + (fr & 1)) * 128 + jc + 16 * n) * rsL[(blk - 1) * 64 + 62 + (fr & 1)] : (f32x4){0.f, 0.f, 0.f, 0.f};
#pragma unroll
                for (int m = 0; m < 4; ++m) {
                    const int r = pm * BM + ai * HALF + wr * 64 + m * 16 + fr;
                    const float rsv = rsL[ai * HALF + wr * 64 + m * 16 + fr];
                    const f32x4 cur = acc[ai][0][m][n] * rsv, bv = acc[ai][1][m][n] * rsv;
                    f32x4 p1, p2;
#pragma unroll
                    for (int e = 0; e < 4; ++e) { p1[e] = dpp_ror1(fr == 15 ? prev[e] : cur[e]); p2[e] = dpp_ror2(fr >= 14 ? prev[e] : cur[e]); }
                    if (kind == 1) {
                        const int t = fr & 3; const float* sc = sconv + (size_t)((r - ROW_S0) >> 2) * 2 * FF + j;
                        if (t == 0) { p1 = *(const f32x4*)(sc + FF); p2 = *(const f32x4*)sc; } else if (t == 1) { p2 = *(const f32x4*)(sc + FF); }
                    }
                    const f32x4 ac = bs + w0 * p2 + w1 * p1 + w2 * cur;
                    const f32x2 g0 = gelu_pk((f32x2){ac[0], ac[1]}), g1 = gelu_pk((f32x2){ac[2], ac[3]});
                    st_wt8(H + (size_t)r * FF + j, cvt_pk_bf16(g0.x * bv[0], g0.y * bv[1]), cvt_pk_bf16(g1.x * bv[2], g1.y * bv[3]));
                    if (kind == 0 && blk == 0 && m == 0 && fr < 2) {
                        float* hd = head + ((size_t)(pm * 2 + fr) * 2) * FF + j; st_wt16(hd, cur); st_wt16(hd + FF, bv); }
                    if (((kind != 2 && blk == 3 && m == 3) || (kind == 2 && blk == 0 && m == 0)) && fr >= 14) {
                        st_wt16(tail + ((size_t)pm * 2 + (fr - 14)) * FF + j, cur);
                        if (kind == 0 && (pm & 7) == 7) *(f32x4*)(out_cp + ((size_t)(pm >> 3) * 2 + (fr - 14)) * FF + j) = cur;
                    }
                    if (kind == 1 && (fr & 3) >= 2) *(f32x4*)(out_cs + ((size_t)((r - ROW_S0) >> 2) * 2 + ((fr & 3) - 2)) * FF + j) = cur;
                    prev = cur;
                }
            }
        }
    }
};

struct FixCtx { const float* tail; const float* head; bf16_t* H; const float* cw; const float* cb; };
struct ChainOrder {
    StaticOrder so; int n_main, ex_pm, ex_pn;
    const unsigned* dep; unsigned need; int dep_kind; unsigned* sig; unsigned* tmo; FixCtx fx;
    __device__ __forceinline__ void init(int Mrows, int N, int Gv, int vc, int expm, int expn) {
        so.init(Mrows, N, Gv, vc < 0 ? 0 : vc); n_main = (vc >= 0 && so.nwg > vc) ? (so.nwg - vc + Gv - 1) / Gv : 0; ex_pm = expm; ex_pn = expn;
        dep = nullptr; need = 0u; dep_kind = 0; sig = nullptr; tmo = nullptr;
    }
    __device__ __forceinline__ bool next(int i, Unit& u) const {
        if (i < n_main) return so.next(i, u);
        if (i == n_main && ex_pm >= 0) { u.pm = ex_pm; u.pn = ex_pn; return true; }
        return false;
    }
    __device__ __forceinline__ void poll(const unsigned* w, unsigned code) const {
        const unsigned long long t0 = __builtin_amdgcn_s_memrealtime(); unsigned polls = 0;
        while ((unsigned)__builtin_amdgcn_readfirstlane(__hip_atomic_load(w, __ATOMIC_RELAXED, __HIP_MEMORY_SCOPE_AGENT)) < need) {
            if ((++polls & 255u) == 0u && __builtin_amdgcn_readfirstlane(__hip_atomic_load(tmo, __ATOMIC_RELAXED, __HIP_MEMORY_SCOPE_AGENT)) != 0u) break;
            if (__builtin_amdgcn_s_memrealtime() - t0 > 2000000ull) { if ((threadIdx.x & 63) == 0) { __hip_atomic_store(tmo + 1, code, __ATOMIC_RELAXED, __HIP_MEMORY_SCOPE_AGENT); __hip_atomic_store(tmo, 1u, __ATOMIC_RELAXED, __HIP_MEMORY_SCOPE_AGENT); } break; }
            __builtin_amdgcn_s_sleep(2); }
    }
    __device__ __forceinline__ void a_ready(const Unit& u) const {
        if (dep_kind == 0) return;
        const int wid = __builtin_amdgcn_readfirstlane((int)threadIdx.x >> 6);
        const bool fix = dep_kind == 2 && u.pm < 64; const int src = (u.pm & 7) == 0 ? 66 : u.pm - 1;
        if (wid == 0) {
            poll(dep + 64 * u.pm, 0x600u | (unsigned)u.pm);
            if (fix) poll(dep + 64 * src, 0x700u | (unsigned)u.pm);
            __builtin_amdgcn_fence(__ATOMIC_ACQUIRE, "agent");
            asm volatile("s_waitcnt vmcnt(0)" ::: "memory");
        }
        asm volatile("" ::: "memory"); __builtin_amdgcn_s_barrier(); asm volatile("" ::: "memory");
        if (fix) {
            if (wid < 4) {
                constexpr int FF = 2816;
                const float* t0 = fx.tail + (size_t)src * 2 * FF; const float* t1 = t0 + FF;
                const float* a0 = fx.head + (size_t)u.pm * 4 * FF; const float* b0 = a0 + FF; const float* a1 = a0 + 2 * FF; const float* b1 = a0 + 3 * FF;
                int t_ = threadIdx.x; asm volatile("" : "+v"(t_));
                for (int j = 2 * t_; j < FF; j += 512) {
                    const f32x2 T0 = *(const f32x2*)(t0 + j), T1 = *(const f32x2*)(t1 + j), A0 = *(const f32x2*)(a0 + j), B0 = *(const f32x2*)(b0 + j), A1 = *(const f32x2*)(a1 + j), B1 = *(const f32x2*)(b1 + j);
                    const f32x2 W0 = *(const f32x2*)(fx.cw + j), W1 = *(const f32x2*)(fx.cw + FF + j), W2 = *(const f32x2*)(fx.cw + 2 * FF + j), CB = *(const f32x2*)(fx.cb + j);
                    const f32x2 g0 = gelu_pk(CB + W0 * T0 + W1 * T1 + W2 * A0), g1 = gelu_pk(CB + W0 * T1 + W1 * A0 + W2 * A1);
                    *(unsigned*)(fx.H + (size_t)(u.pm * 256) * FF + j) = cvt_pk_bf16(g0.x * B0[0], g0.y * B0[1]);
                    *(unsigned*)(fx.H + (size_t)(u.pm * 256 + 1) * FF + j) = cvt_pk_bf16(g1.x * B1[0], g1.y * B1[1]);
                }
                asm volatile("s_waitcnt vmcnt(0)" ::: "memory");
            }
            asm volatile("" ::: "memory"); __builtin_amdgcn_s_barrier(); asm volatile("" ::: "memory");
        }
    }
    __device__ __forceinline__ void done(const Unit& u) const {
        if (sig == nullptr) return;
        asm volatile("s_waitcnt vmcnt(0)" ::: "memory");
        if ((threadIdx.x & 63) == 0) __hip_atomic_fetch_add(sig + 64 * u.pm, 1u, __ATOMIC_RELAXED, __HIP_MEMORY_SCOPE_AGENT);
    }
};
template <class Epi, class Sched, bool ALIGN_EPI = false, bool SP2 = false>
__device__ __forceinline__ void gemm_phase(PG8_LAS unsigned char* lds, const Gemm g, const Sched& S, const Epi& E) {
    int tid_ = threadIdx.x; asm volatile("" : "+v"(tid_));
    float z_ = 0.f; asm volatile("" : "+v"(z_));
    const int tid = tid_, wid = __builtin_amdgcn_readfirstlane(tid >> 6), lane = tid & 63, wr = wid >> 2, wc = wid & 3, fr = lane & 15, fq = lane >> 4;
    const int K = g.K, nt = K / BK;
    unsigned voffA[2], voffB[2];
#pragma unroll
    for (int i = 0; i < 2; ++i) { int R, C; stage_rc(tid * 16 + i * 8192, R, C); const int Rb = Epi::PERM ? ((R & ~31) + perm32(R & 31)) : R;
        voffA[i] = (unsigned)(R * K + C) * 2u; voffB[i] = (unsigned)(Rb * K + C) * 2u; }
    const size_t kstep = (size_t)(BK * 2);
    const size_t hstep = (size_t)HALF * K * 2;
    const size_t tstep = 2 * hstep;
    const unsigned ldsw = (unsigned)wid * 1024u;
    const int aoff = lds_byte(wr * 64 + fr, fq * 8), boff = lds_byte(wc * 32 + fr, fq * 8);
#define PG8_SA(b, h) (((b) * 2 + (h)) * HTB)
#define PG8_SB(b, h) ((4 + (b) * 2 + (h)) * HTB)
#define PG8_STAGE(bufoff, gbase, voff) do { _Pragma("unroll") for (int _i = 0; _i < 2; ++_i) \
        __builtin_amdgcn_global_load_lds((const unsigned*)((const char*)(gbase) + (voff)[_i]), (PG8_LAS unsigned*)(lds + (bufoff) + ldsw + _i * 8192), 16, 0, 0); } while (0)
#define PG8_LDA(dst, b, h) do { _Pragma("unroll") for (int m = 0; m < 4; ++m) _Pragma("unroll") for (int k = 0; k < 2; ++k) dst[m][k] = *(const PG8_LAS bf16x8*)(lds + PG8_SA(b, h) + aoff + m * 2048 + k * 1024); } while (0)
#define PG8_LDB(dst, b, h) do { _Pragma("unroll") for (int n = 0; n < 2; ++n) _Pragma("unroll") for (int k = 0; k < 2; ++k) dst[n][k] = *(const PG8_LAS bf16x8*)(lds + PG8_SB(b, h) + boff + n * 2048 + k * 1024); } while (0)
#define PG8_MMA(ai, bj, At, Bt) do { __builtin_amdgcn_s_setprio(1); _Pragma("unroll") for (int m = 0; m < 4; ++m) _Pragma("unroll") for (int n = 0; n < 2; ++n) _Pragma("unroll") for (int k = 0; k < 2; ++k) \
        acc[ai][bj][m][n] = __builtin_amdgcn_mfma_f32_16x16x32_bf16(Bt[n][k], At[m][k], acc[ai][bj][m][n], 0, 0, 0); __builtin_amdgcn_s_setprio(0); } while (0)
#define PG8_WAIT_V(n) asm volatile("s_waitcnt vmcnt(" #n ")" ::: "memory")
#define PG8_WAIT_L(n) asm volatile("s_waitcnt lgkmcnt(" #n ")" ::: "memory")
#define PG8_BAR __builtin_amdgcn_s_barrier()
#define PG8_SCHED __builtin_amdgcn_sched_barrier(0)
    Unit cur, nxt; int ui = 0;
    if (!S.next(0, cur)) return;
    f32x4 acc[2][2][4][2];
#pragma unroll
    for (int a = 0; a < 2; ++a)
#pragma unroll
        for (int b = 0; b < 2; ++b)
#pragma unroll
            for (int m = 0; m < 4; ++m)
#pragma unroll
                for (int n = 0; n < 2; ++n) acc[a][b][m][n] = (f32x4){z_, z_, z_, z_};
    bf16x8 At[4][2], B0[2][2], B1[2][2];
    const char* cA = (const char*)g.A + (size_t)cur.pm * tstep; const char* cB = (const char*)g.Bt + (size_t)cur.pn * tstep;
    S.a_ready(cur);
    if constexpr (SP2) {
        PG8_STAGE(PG8_SB(0, 0), cB, voffB); PG8_STAGE(PG8_SB(0, 1), cB + hstep, voffB); PG8_STAGE(PG8_SA(0, 0), cA, voffA); PG8_STAGE(PG8_SA(0, 1), cA + hstep, voffA);
        if (wr == 1) PG8_BAR;
        PG8_WAIT_V(2); PG8_BAR;
        PG8_STAGE(PG8_SB(1, 0), cB + kstep, voffB); PG8_STAGE(PG8_SA(1, 0), cA + kstep, voffA); PG8_STAGE(PG8_SB(1, 1), cB + hstep + kstep, voffB);
        PG8_WAIT_V(6); PG8_BAR;
    } else {
        PG8_STAGE(PG8_SB(0, 0), cB, voffB); PG8_STAGE(PG8_SA(0, 0), cA, voffA); PG8_STAGE(PG8_SB(0, 1), cB + hstep, voffB); PG8_STAGE(PG8_SA(0, 1), cA + hstep, voffA);
        if (wr == 1) PG8_BAR;
        PG8_WAIT_V(4); PG8_BAR;
        PG8_STAGE(PG8_SB(1, 0), cB + kstep, voffB); PG8_STAGE(PG8_SA(1, 0), cA + kstep, voffA); PG8_STAGE(PG8_SB(1, 1), cB + hstep + kstep, voffB);
        PG8_WAIT_V(6); PG8_BAR;
    }
    for (;;) {
        const bool has_next = S.next(ui + 1, nxt);
        const char* nA = has_next ? (const char*)g.A + (size_t)nxt.pm * tstep : cA; const char* nB = has_next ? (const char*)g.Bt + (size_t)nxt.pn * tstep : cB;
        for (int t = 0; t < nt; t += 2) {
            const bool last = (t == nt - 2);
            const char* a1 = cA + (size_t)(t + 1) * kstep;
            const char* a2 = last ? nA : cA + (size_t)(t + 2) * kstep; const char* b2 = last ? nB : cB + (size_t)(t + 2) * kstep;
            const char* a3 = a2 + kstep; const char* b3 = b2 + kstep;
            if (last && has_next) S.a_ready(nxt);
            if constexpr (SP2) {
            PG8_LDB(B0, 0, 0); PG8_LDB(B1, 0, 1); PG8_SCHED; PG8_LDA(At, 0, 0); PG8_STAGE(PG8_SA(1, 1), a1 + hstep, voffA);
            PG8_WAIT_V(8); PG8_WAIT_L(0); PG8_BAR; PG8_MMA(0, 0, At, B0); PG8_MMA(0, 1, At, B1); PG8_BAR; PG8_SCHED;
            PG8_LDA(At, 0, 1); PG8_STAGE(PG8_SB(0, 0), b2, voffB); PG8_STAGE(PG8_SB(0, 1), b2 + hstep, voffB); PG8_STAGE(PG8_SA(0, 0), a2, voffA);
            PG8_WAIT_V(8); PG8_WAIT_L(0); PG8_BAR; PG8_MMA(1, 0, At, B0); PG8_MMA(1, 1, At, B1); PG8_BAR; PG8_SCHED;
            PG8_LDB(B0, 1, 0); PG8_LDB(B1, 1, 1); PG8_SCHED; PG8_LDA(At, 1, 0); PG8_STAGE(PG8_SA(0, 1), a2 + hstep, voffA);
            PG8_WAIT_V(8); PG8_WAIT_L(0); PG8_BAR; PG8_MMA(0, 0, At, B0); PG8_MMA(0, 1, At, B1); PG8_BAR; PG8_SCHED;
            PG8_LDA(At, 1, 1); PG8_STAGE(PG8_SB(1, 0), b3, voffB); PG8_STAGE(PG8_SB(1, 1), b3 + hstep, voffB); PG8_STAGE(PG8_SA(1, 0), a3, voffA);
            PG8_WAIT_V(8); PG8_WAIT_L(0); PG8_BAR; PG8_MMA(1, 0, At, B0); PG8_MMA(1, 1, At, B1); PG8_BAR; PG8_SCHED;
            } else {
            PG8_LDB(B0, 0, 0); PG8_SCHED; PG8_LDA(At, 0, 0); PG8_STAGE(PG8_SA(1, 1), a1 + hstep, voffA);
            PG8_WAIT_L(8); PG8_BAR; PG8_WAIT_L(0); PG8_MMA(0, 0, At, B0); PG8_BAR; PG8_SCHED;
            PG8_LDB(B1, 0, 1); PG8_STAGE(PG8_SB(0, 0), b2, voffB);
            PG8_BAR; PG8_WAIT_L(0); PG8_MMA(0, 1, At, B1); PG8_BAR;
            PG8_LDA(At, 0, 1); PG8_STAGE(PG8_SA(0, 0), a2, voffA);
            PG8_BAR; PG8_WAIT_L(0); PG8_MMA(1, 0, At, B0); PG8_BAR; PG8_SCHED;
            PG8_STAGE(PG8_SB(0, 1), b2 + hstep, voffB);
            PG8_WAIT_V(6); PG8_BAR; PG8_MMA(1, 1, At, B1); PG8_BAR;
            PG8_LDB(B0, 1, 0); PG8_SCHED; PG8_LDA(At, 1, 0); PG8_STAGE(PG8_SA(0, 1), a2 + hstep, voffA);
            PG8_WAIT_L(8); PG8_BAR; PG8_WAIT_L(0); PG8_MMA(0, 0, At, B0); PG8_BAR; PG8_SCHED;
            PG8_LDB(B1, 1, 1); PG8_STAGE(PG8_SB(1, 0), b3, voffB);
            PG8_BAR; PG8_WAIT_L(0); PG8_MMA(0, 1, At, B1); PG8_BAR;
            PG8_LDA(At, 1, 1); PG8_STAGE(PG8_SA(1, 0), a3, voffA);
            PG8_BAR; PG8_WAIT_L(0); PG8_MMA(1, 0, At, B0); PG8_BAR; PG8_SCHED;
            PG8_STAGE(PG8_SB(1, 1), b3 + hstep, voffB);
            PG8_WAIT_V(6); PG8_BAR; PG8_MMA(1, 1, At, B1); PG8_BAR;
            }
        }
        if constexpr (ALIGN_EPI) { if (wr == 0) PG8_BAR; }
        if constexpr (!Epi::AFTER_DRAIN) { E(acc, cur, wr, wc, fr, fq); S.done(cur); }
        if (!has_next) break;
#pragma unroll
        for (int a = 0; a < 2; ++a)
#pragma unroll
            for (int b = 0; b < 2; ++b)
#pragma unroll
                for (int m = 0; m < 4; ++m)
#pragma unroll
                    for (int n = 0; n < 2; ++n) acc[a][b][m][n] = (f32x4){z_, z_, z_, z_};
        cur = nxt; cA = nA; cB = nB; ++ui;
        if constexpr (ALIGN_EPI) { if (wr == 1) PG8_BAR; }
    }
    PG8_WAIT_V(0);
    if constexpr (!ALIGN_EPI) { if (wr == 0) PG8_BAR; }
    PG8_BAR;
    if constexpr (Epi::AFTER_DRAIN) { E.fused(acc, cur, wr, wc, fr, fq, lds, wid, lane); S.done(cur); }
#undef PG8_SA
#undef PG8_SB
#undef PG8_STAGE
#undef PG8_LDA
#undef PG8_LDB
#undef PG8_MMA
#undef PG8_WAIT_V
#undef PG8_WAIT_L
#undef PG8_BAR
#undef PG8_SCHED
}
}

namespace mk {
using pg8::bf16_t; using pg8::f32x4; using pg8::u32x4; using pg8::bf16x8; using pg8::u32x2; using pg8::cvt_pk_bf16;
typedef float f32x2 __attribute__((ext_vector_type(2)));
#define LAS __attribute__((address_space(3)))

constexpr int D = 1024, DIN = 2560, DFF = 2816, NAB = 5632, DEPTH = 4, DREC = 512;
constexpr int NPROMPT = 16384, NSAMP = 512, NMETA = 16, SEQ = 2048, NB = 8, NDB = 128;
constexpr int ROW_S0 = 16384, ROW_M0 = 16896, MROWS = 16912, MP = 17152;
constexpr int NTHR = 512;
constexpr float EPS = 1e-6f;
constexpr int NRUN = 256, NGITEM = 260;

constexpr size_t O_YP = 0, O_YS = 16777216, O_PP = 17301504, O_RP = 17547264, O_CP = 19644416, O_PS = 19824640, O_RS = 23756800, O_CS = 57311232;

constexpr size_t MiB = 1u << 20;
constexpr size_t WS_WIN = 1 * MiB, WS_WOUT = 21 * MiB, WS_WAB = 29 * MiB, WS_WDN = 73 * MiB, WS_XRES = 95 * MiB, WS_XB = 162 * MiB, WS_LB = 197 * MiB, WS_DV = 197 * MiB + 65536,
                 WS_TAIL = 198 * MiB, WS_HEAD = 200 * MiB, WS_Z = 204 * MiB, WS_Y = 288 * MiB, WS_R2 = 322 * MiB, WS_H = WS_R2, WS_DS = WS_R2, WS_SST = WS_R2 + 65 * MiB, WS_SSQ = 420 * MiB, WS_TOTAL = 431 * MiB;
static_assert(WS_WIN + (size_t)DEPTH * DIN * D * 2 <= WS_WOUT && WS_WOUT + (size_t)DEPTH * D * D * 2 <= WS_WAB && WS_WAB + (size_t)DEPTH * NAB * D * 2 <= WS_WDN && WS_WDN + (size_t)DEPTH * D * DFF * 2 <= WS_XRES, "ws map 1");
static_assert(WS_XRES + (size_t)MP * D * 4 <= WS_XB && WS_XB + (size_t)MP * D * 2 <= WS_LB && WS_SSQ + (size_t)9 * MP * 16 * 4 <= WS_TOTAL && WS_DV + (size_t)NGITEM * 128 * 4 <= WS_TAIL, "ws map 2");
static_assert(WS_TAIL + (size_t)67 * 2 * DFF * 4 <= WS_HEAD && WS_HEAD + (size_t)64 * 4 * DFF * 4 <= WS_Z && WS_Z + (size_t)MP * DIN * 2 <= WS_Y && WS_Y + (size_t)MP * D * 2 <= WS_R2, "ws map 3");
static_assert(WS_H + (size_t)MP * DFF * 2 <= WS_SSQ && WS_DS + (size_t)NGITEM * 16384 * 4 <= WS_SST && WS_SST + (size_t)NRUN * 16384 * 4 <= WS_SSQ, "ws map 4");

constexpr int RING_BYTES = 131072, MISC_OFF = RING_BYTES + 320, HALO_OFF = RING_BYTES + 1024, LDS_BYTES = 147456;
constexpr size_t WS_CTL = 0, CTL_ZERO_BYTES = 278528; constexpr int CW_BAR = 4096, CW_CNT = 16384;
constexpr int L_QT = 0, L_KT = 17408, L_KTT = 34816, L_VT = 53248, L_AL = 71680, L_STL = 80896, L_TOT = 115712, L_EGM = 119808, L_EGL = 120320, L_SSQL = 120832, L_EGD = 121344, L_DSUP = 121856;
constexpr int PQ = 136, PS = 72;

struct Params {
    const float *x_prompt, *x_sample, *state_pool, *state_rec, *state_conv, *meta, *norm1_g, *w_in, *w_pool, *pool_scale, *lb_raw, *rec_norm_g, *w_out, *norm2_g, *w_a, *w_b, *conv_w, *conv_b, *w_down, *final_g;
    float* out; unsigned char* ws;
};

__device__ __forceinline__ float bf_lo(unsigned u) { return __uint_as_float(u << 16); }
__device__ __forceinline__ float bf_hi(unsigned u) { return __uint_as_float(u & 0xffff0000u); }
__device__ __forceinline__ float bf1(bf16_t u) { return __uint_as_float((unsigned)u << 16); }
__device__ __forceinline__ float wave_sum(float v) {
#pragma unroll
    for (int o = 1; o < 64; o <<= 1) v += __shfl_xor(v, o);
    return v;
}
__device__ __forceinline__ float rcp_(float x) { return __builtin_amdgcn_rcpf(x); }
__device__ __forceinline__ float sigmoidf_(float x) { return rcp_(1.0f + __expf(-x)); }
#define LDS_WAIT() asm volatile("s_waitcnt lgkmcnt(0)" ::: "memory")
__device__ __forceinline__ f32x4 ozero4() { float z = 0.f; asm volatile("" : "+v"(z)); return (f32x4){z, z, z, z}; }
__device__ __forceinline__ u32x4 ozero4u() { unsigned z = 0u; asm volatile("" : "+v"(z)); return (u32x4){z, z, z, z}; }
__device__ __forceinline__ int obid() { int b = blockIdx.x; asm volatile("" : "+s"(b)); return b; }
__device__ __forceinline__ int otid() { int t = threadIdx.x; asm volatile("" : "+v"(t)); return t; }

#define XB_TMO      128
#define XB_XCNT(j)  (256  + 64 * (j))
#define XB_XSUB(j)  (1280 + 64 * (j))
#define XB_XGEN(j)  (2304 + 64 * (j))
#define XB_TOP      3328
#define XB_TOPGEN   3392
#define XCD_BAR_WORDS 3456
#define XB_SPIN_CAP (1u << 18)

__device__ __forceinline__ unsigned xb_ld(unsigned* p)              { return __hip_atomic_load(p, __ATOMIC_RELAXED, __HIP_MEMORY_SCOPE_AGENT); }
__device__ __forceinline__ unsigned xb_add(unsigned* p, unsigned v) { return __hip_atomic_fetch_add(p, v, __ATOMIC_RELAXED, __HIP_MEMORY_SCOPE_AGENT); }
__device__ __forceinline__ unsigned xb_xcc_id() { return (unsigned)__builtin_amdgcn_s_getreg((3 << 11) | 20) & 0xFu; }
#define XB_SPIN(cond, bar) do { unsigned _sp = 0; while (cond) { __builtin_amdgcn_s_sleep(1); \
    if ((++_sp & 255u) == 0u) { if (xb_ld(&(bar)[XB_TMO])) break; if (_sp > XB_SPIN_CAP) { atomicAdd(&(bar)[XB_TMO], 1u); break; } } } } while (0)

struct XcdBarrier {
    unsigned* bar; unsigned x;
    volatile LAS unsigned* st;
};

__device__ __forceinline__ XcdBarrier xcd_barrier_post(unsigned* bar, volatile LAS unsigned* st) {
    XcdBarrier b; b.bar = bar; b.x = xb_xcc_id(); b.st = st;
    if (threadIdx.x == 0) (void)xb_add(&bar[XB_XCNT(b.x)], 1u);
    return b;
}
__device__ __forceinline__ void xcd_barrier_complete(unsigned* bar, unsigned x, unsigned& nloc, unsigned& nx) {
    const unsigned G = gridDim.x * gridDim.y * gridDim.z;
    unsigned sum, cnt, mine, sp = 0u;
    for (;;) {
        sum = 0u; cnt = 0u; mine = 0u;
#pragma unroll
        for (unsigned j = 0; j < 16; ++j) { const unsigned c = xb_ld(&bar[XB_XCNT(j)]); sum += c; cnt += (c > 0u) ? 1u : 0u; mine = (j == x) ? c : mine; }
        if (sum == G) break;
        __builtin_amdgcn_s_sleep(1);
        if ((++sp & 255u) == 0u) { if (xb_ld(&bar[XB_TMO])) break; if (sp > XB_SPIN_CAP) { atomicAdd(&bar[XB_TMO], 1u); break; } }
    }
    nloc = mine > 0u ? mine : 1u; nx = cnt > 0u ? cnt : 1u;
}

__device__ __forceinline__ void xcd_barrier(const XcdBarrier& b) {
    asm volatile("s_waitcnt vmcnt(0)" ::: "memory");
    __syncthreads();
    if (threadIdx.x == 0) {
        unsigned* bar = b.bar;
        __builtin_amdgcn_s_waitcnt(0);
        unsigned nloc = b.st[0], nx = b.st[1];
        if (nloc == 0u) { xcd_barrier_complete(bar, b.x, nloc, nx); b.st[0] = nloc; b.st[1] = nx; }
        const unsigned old = xb_add(&bar[XB_XSUB(b.x)], 1u);
        const unsigned gen = old / nloc;
        if (old + 1u == (gen + 1u) * nloc) {
            __builtin_amdgcn_fence(__ATOMIC_RELEASE, "agent");
            asm volatile("s_waitcnt vmcnt(0)" ::: "memory");
            const unsigned og = xb_add(&bar[XB_TOP], 1u);
            const unsigned tg = og / nx;
            if (og + 1u == (tg + 1u) * nx) xb_add(&bar[XB_TOPGEN], 1u);
            else XB_SPIN(xb_ld(&bar[XB_TOPGEN]) == tg, bar);
            __builtin_amdgcn_fence(__ATOMIC_ACQUIRE, "agent");
            xb_add(&bar[XB_XGEN(b.x)], 1u);
            asm volatile("s_waitcnt vmcnt(0)" ::: "memory");
        } else {
            XB_SPIN(xb_ld(&bar[XB_XGEN(b.x)]) == gen, bar);
            __builtin_amdgcn_fence(__ATOMIC_ACQUIRE, "agent");
            asm volatile("s_waitcnt vmcnt(0)" ::: "memory");
        }
    }
    __syncthreads();
}

__device__ __forceinline__ void tr_item64(const float* W, int N, int ldk, const float* gk, bf16_t* WT, int dst_row, int k0, int n) {
    float w[64];
#pragma unroll
    for (int kk = 0; kk < 64; ++kk) w[kk] = W[(size_t)(k0 + kk) * N + n];
    if (gk) {
#pragma unroll
        for (int kk = 0; kk < 64; ++kk) w[kk] *= gk[k0 + kk];
    }
    bf16_t* o = WT + (size_t)dst_row * ldk + k0;
#pragma unroll
    for (int c = 0; c < 8; ++c) { u32x4 v; v.x = cvt_pk_bf16(w[8 * c], w[8 * c + 1]); v.y = cvt_pk_bf16(w[8 * c + 2], w[8 * c + 3]); v.z = cvt_pk_bf16(w[8 * c + 4], w[8 * c + 5]); v.w = cvt_pk_bf16(w[8 * c + 6], w[8 * c + 7]); *(u32x4*)(o + 8 * c) = v; }
}
__device__ __forceinline__ void fold_block(const Params& p, LAS unsigned char* lds, int l, int g, int nb) {
    const int tid = otid();
    LAS float* As = (LAS float*)lds; LAS float* Bs = As + 128 * 132;
    const float* wp = p.w_pool + ((size_t)l * 4 + g) * 16384; const float* sc = p.pool_scale + l * 512 + g * 128; const float* wo = p.w_out + (size_t)l * D * D + (size_t)(g * 128) * D + 64 * nb;
#pragma unroll
    for (int k = 0; k < 8; ++k) { const int q = tid + 512 * k, c = q >> 5, d4 = (q & 31) * 4; const f32x4 v = *(const f32x4*)(wp + c * 128 + d4) * *(const f32x4*)(sc + d4);
        As[(d4 + 0) * 132 + c] = v[0]; As[(d4 + 1) * 132 + c] = v[1]; As[(d4 + 2) * 132 + c] = v[2]; As[(d4 + 3) * 132 + c] = v[3]; }
#pragma unroll
    for (int k = 0; k < 4; ++k) { const int q = tid + 512 * k, d = q >> 4, n4 = (q & 15) * 4; *(LAS f32x4*)(Bs + d * 68 + n4) = *(const f32x4*)(wo + (size_t)d * D + n4); }
    __syncthreads();
    const int tc = tid >> 4, tn = tid & 15;
    f32x4 acc[4];
#pragma unroll
    for (int ci = 0; ci < 4; ++ci) acc[ci] = (f32x4){0.f, 0.f, 0.f, 0.f};
#pragma unroll 8
    for (int d = 0; d < 128; ++d) { const f32x4 a = *(const LAS f32x4*)(As + d * 132 + 4 * tc), b = *(const LAS f32x4*)(Bs + d * 68 + 4 * tn);
#pragma unroll
        for (int ci = 0; ci < 4; ++ci) acc[ci] += b * a[ci]; }
    bf16_t* WT = (bf16_t*)(p.ws + WS_WOUT) + (size_t)l * D * D;
#pragma unroll
    for (int nj = 0; nj < 4; ++nj) { u32x2 w; w.x = cvt_pk_bf16(acc[0][nj], acc[1][nj]); w.y = cvt_pk_bf16(acc[2][nj], acc[3][nj]);
        *(u32x2*)(WT + (size_t)(64 * nb + 4 * tn + nj) * D + g * 128 + 4 * tc) = w; }
    __syncthreads();
}

__device__ __forceinline__ void prologue(const Params& p, LAS unsigned char* lds, int parts) {
    const int tid = otid(), lane = tid & 63, wave = __builtin_amdgcn_readfirstlane(tid >> 6);
    const int gw = blockIdx.x * 8 + wave, NGW = gridDim.x * 8;
    bf16_t* WIN = (bf16_t*)(p.ws + WS_WIN); bf16_t* WOUT = (bf16_t*)(p.ws + WS_WOUT); bf16_t* WAB = (bf16_t*)(p.ws + WS_WAB); bf16_t* WDN = (bf16_t*)(p.ws + WS_WDN);
    constexpr int I_IN = 16 * 40, I_OUT = 8 * 16, I_A = 16 * 44, I_DN = 44 * 16, PER_L = I_IN + I_OUT + 2 * I_A + I_DN;
    if (parts & 1)
    for (int it = blockIdx.x; it < DEPTH * 64; it += gridDim.x) fold_block(p, lds, it >> 6, (it >> 4) & 3, it & 15);
    if (parts & 1)
    for (int it = gw; it < DEPTH * PER_L; it += NGW) {
        const int l = it / PER_L; int r = it % PER_L;
        if (r < I_IN) { const int kb = r / 40, n = 64 * (r % 40) + lane; tr_item64(p.w_in + (size_t)l * D * DIN, DIN, D, p.norm1_g + l * D, WIN + (size_t)l * DIN * D, n, 64 * kb, n); continue; } r -= I_IN;
        if (r < I_OUT) { const int kb = 8 + r / 16, n = 64 * (r % 16) + lane; tr_item64(p.w_out + (size_t)l * D * D, D, D, nullptr, WOUT + (size_t)l * D * D, n, 64 * kb, n); continue; } r -= I_OUT;
        if (r < 2 * I_A) { const int isb = r >= I_A; if (isb) r -= I_A; const int kb = r / 44, n = 64 * (r % 44) + lane;
            tr_item64((isb ? p.w_b : p.w_a) + (size_t)l * D * DFF, DFF, D, p.norm2_g + l * D, WAB + (size_t)l * NAB * D, (n >> 7) * 256 + (n & 127) + (isb ? 128 : 0), 64 * kb, n); continue; } r -= 2 * I_A;
        { const int kb = r / 16, n = 64 * (r % 16) + lane; tr_item64(p.w_down + (size_t)l * DFF * D, D, DFF, nullptr, WDN + (size_t)l * D * DFF, n, 64 * kb, n); }
    }
    float* XRES = (float*)(p.ws + WS_XRES); bf16_t* XB = (bf16_t*)(p.ws + WS_XB); float* SSQ = (float*)(p.ws + WS_SSQ);
    if (parts & 2)
    for (int r = gw; r < MP; r += NGW) {
        const float* src = r < ROW_S0 ? p.x_prompt + (size_t)r * D : (r < ROW_M0 ? p.x_sample + (size_t)(r - ROW_S0) * D : (r < MROWS ? p.meta + (size_t)(r - ROW_M0) * D : nullptr));
        f32x4 v[4]; float s = 0.f;
#pragma unroll
        for (int j = 0; j < 4; ++j) { v[j] = src ? *(const f32x4*)(src + 4 * lane + 256 * j) : (f32x4){0.f, 0.f, 0.f, 0.f}; s += (v[j][0] * v[j][0] + v[j][1] * v[j][1]) + (v[j][2] * v[j][2] + v[j][3] * v[j][3]); }
        s = wave_sum(s);
#pragma unroll
        for (int j = 0; j < 4; ++j) { *(f32x4*)(XRES + (size_t)r * D + 4 * lane + 256 * j) = v[j];
            u32x2 w; w.x = cvt_pk_bf16(v[j][0], v[j][1]); w.y = cvt_pk_bf16(v[j][2], v[j][3]); *(u32x2*)(XB + (size_t)r * D + 4 * lane + 256 * j) = w; }
        if (lane < 16) SSQ[(size_t)r * 16 + lane] = lane == 0 ? s : 0.f;
    }
    if (blockIdx.x == 0) {
        float* LB = (float*)(p.ws + WS_LB);
        const int j = tid; float v0 = p.lb_raw[j], v1 = p.lb_raw[512 + j], v2 = p.lb_raw[1024 + j], v3 = p.lb_raw[1536 + j];
        const float mx = fmaxf(fmaxf(v0, v1), fmaxf(v2, v3));
        const float e0 = expf(v0 - mx), e1 = expf(v1 - mx), e2 = expf(v2 - mx), e3 = expf(v3 - mx), inv = 1.0f / (e0 + e1 + e2 + e3);
        LB[j] = 0.f; LB[512 + j] = e1 * inv; LB[1024 + j] = (e1 + e2) * inv; LB[1536 + j] = (e1 + e2 + e3) * inv;
    }
}

__device__ __forceinline__ void pool_item(const Params& p, int l, int item, LAS unsigned char* lds) {
    const int tid = otid();
    const bf16_t* Z = (const bf16_t*)(p.ws + WS_Z); bf16_t* Y = (bf16_t*)(p.ws + WS_Y);
    const bool is_meta = (item == 512);
    const int t0 = is_meta ? ROW_M0 : 32 * item, nrows = is_meta ? 16 : 32;
    const bool seq_start = (!is_meta) && ((t0 & (SEQ - 1)) == 0);
    LAS bf16_t* U = (LAS bf16_t*)lds;
    for (int q = tid; q < (15 + nrows) * 64; q += NTHR) {
        const int j = q >> 6, c16 = q & 63;
        int row = t0 - 15 + j;
        if (j < 15) { if (is_meta) row = -1; else if (seq_start) row = ROW_M0 + 1 + j; }
        const u32x4 v = row >= 0 ? *(const u32x4*)(Z + (size_t)row * DIN + 8 * c16) : ozero4u();
        *(LAS u32x4*)(U + j * 512 + 8 * c16) = v;
    }
    __syncthreads();
    const int cp = tid & 255, half = tid >> 8, W = 2 << (cp >> 6);
    if (16 * half < nrows) {
        float* pp = nullptr;
        if (!is_meta && half == 1 && (t0 & (SEQ - 1)) == SEQ - 32) pp = p.out + O_PP + ((size_t)(l * NB + (t0 >> 11)) * 15) * 512;
        for (int i = 0; i < 16; ++i) {
            const int e = 15 + 16 * half + i;
            float s0 = 0.f, s1 = 0.f;
            for (int j = 0; j < W; ++j) { const unsigned u = *(const LAS unsigned*)(U + (e - j) * 512 + 2 * cp); s0 += bf_lo(u); s1 += bf_hi(u); }
            const unsigned uc = *(const LAS unsigned*)(U + e * 512 + 2 * cp);
            const int cnt = is_meta ? (i + 1 < W ? i + 1 : W) : W;
            const float inv = 1.0f / (float)cnt;
            *(unsigned*)(Y + (size_t)(t0 + 16 * half + i) * D + 2 * cp) = cvt_pk_bf16(s0 * inv - bf_lo(uc), s1 * inv - bf_hi(uc));
            if (pp && i >= 1) *(f32x2*)(pp + (size_t)(i - 1) * 512 + 2 * cp) = (f32x2){bf_lo(uc), bf_hi(uc)};
        }
    }
    __syncthreads();
}
__device__ __forceinline__ void pool_sample_item(const Params& p, int l, int item) {
    const int tid = otid(), cp = tid & 255, rs = 2 * item + (tid >> 8), n = rs >> 2, t = rs & 3;
    const bf16_t* Z = (const bf16_t*)(p.ws + WS_Z); bf16_t* Y = (bf16_t*)(p.ws + WS_Y);
    const float* sp = p.state_pool + ((size_t)(l * NDB + n) * 15) * 512 + 2 * cp;
    const int W = 2 << (cp >> 6);
    float s0 = 0.f, s1 = 0.f, u0 = 0.f, u1 = 0.f;
    for (int j = 0; j < W; ++j) {
        const int e = 15 + t - j; float a0, a1;
        if (e >= 15) { const unsigned u = *(const unsigned*)(Z + (size_t)(ROW_S0 + 4 * n + (e - 15)) * DIN + 2 * cp); a0 = bf_lo(u); a1 = bf_hi(u); if (j == 0) { u0 = a0; u1 = a1; } }
        else { const f32x2 a = *(const f32x2*)(sp + (size_t)e * 512); a0 = a[0]; a1 = a[1]; }
        s0 += a0; s1 += a1;
    }
    const float inv = 1.0f / (float)W;
    *(unsigned*)(Y + (size_t)(ROW_S0 + rs) * D + 2 * cp) = cvt_pk_bf16(s0 * inv - u0, s1 * inv - u1);
    float* po = p.out + O_PS + ((size_t)(l * NDB + n) * 15) * 512 + 2 * cp;
    *(f32x2*)(po + (size_t)(11 + t) * 512) = (f32x2){u0, u1};
    for (int i = t; i < 11; i += 4) *(f32x2*)(po + (size_t)i * 512) = *(const f32x2*)(sp + (size_t)(i + 4) * 512);
}

struct GlaIn { unsigned ff[8], vv[8]; };
template <int MODE>
__device__ __forceinline__ void gla_load(GlaIn& in, const bf16_t* Z, int r0, int hh) {
    const int tid = otid(), cp = tid & 63, rg = tid >> 6, d0 = 2 * cp;
#pragma unroll
    for (int i = 0; i < 8; ++i) { const bf16_t* zr = Z + (size_t)(r0 + 8 * rg + i) * DIN + hh * 128 + d0;
        in.ff[i] = *(const unsigned*)(zr + 1024); if (MODE == 0) in.vv[i] = *(const unsigned*)(zr + 1536); }
}
template <int MODE>
__device__ __forceinline__ void gla_prep(LAS unsigned char* lds, const GlaIn& in, const bf16_t* zq, const float* lb, int nvalid) {
    const int tid = otid(), cp = tid & 63, rg = tid >> 6, d0 = 2 * cp;
    const float lb0 = lb[d0], lb1 = lb[d0 + 1];
    const unsigned (&ff)[8] = in.ff; unsigned qq[8], vv[8];
#pragma unroll
    for (int i = 0; i < 8; ++i) { if (MODE == 1) { qq[i] = *(const unsigned*)(zq + (size_t)(8 * rg + i) * DIN + d0); vv[i] = *(const unsigned*)(zq + (size_t)(8 * rg + i) * DIN + d0 + 1024); } else vv[i] = in.vv[i]; }
    float g0[8], g1[8], k0[8], k1[8]; float run0 = 0.f, run1 = 0.f;
#pragma unroll
    for (int i = 0; i < 8; ++i) {
        const bool valid = (8 * rg + i) < nvalid;
        const float f0 = bf_lo(ff[i]), f1 = bf_hi(ff[i]);
        const float e0 = __expf(-f0), e1 = __expf(-f1), s0 = rcp_(1.0f + e0), s1 = rcp_(1.0f + e1);
        float lf0 = __logf(lb0 + (1.0f - lb0) * s0), lf1 = __logf(lb1 + (1.0f - lb1) * s1);
        float kk0 = (1.0f - lb0) * e0 * s0, kk1 = (1.0f - lb1) * e1 * s1;
        if (!valid) { lf0 = 0.f; lf1 = 0.f; kk0 = 0.f; kk1 = 0.f; }
        run0 += lf0; run1 += lf1; g0[i] = run0; g1[i] = run1; k0[i] = kk0; k1[i] = kk1;
    }
    LAS float* TOT = (LAS float*)(lds + L_TOT);
    *(LAS f32x2*)(TOT + rg * 128 + d0) = (f32x2){run0, run1};
    __syncthreads();
    float pre0 = 0.f, pre1 = 0.f, gm0 = 0.f, gm1 = 0.f, gl0 = 0.f, gl1 = 0.f;
#pragma unroll
    for (int g = 0; g < 8; ++g) { const f32x2 t = *(const LAS f32x2*)(TOT + g * 128 + d0);
        if (g < rg) { pre0 += t[0]; pre1 += t[1]; } if (g < 4) { gm0 += t[0]; gm1 += t[1]; } gl0 += t[0]; gl1 += t[1]; }
    LAS bf16_t* QT = (LAS bf16_t*)(lds + L_QT); LAS bf16_t* KT = (LAS bf16_t*)(lds + L_KT); LAS bf16_t* KTT = (LAS bf16_t*)(lds + L_KTT); LAS bf16_t* VT = (LAS bf16_t*)(lds + L_VT);
    float kt0[8], kt1[8];
#pragma unroll
    for (int i = 0; i < 8; ++i) {
        const float G0 = pre0 + g0[i], G1 = pre1 + g1[i];
        const float ek0 = __expf(gm0 - G0), ek1 = __expf(gm1 - G1);
        kt0[i] = k0[i] * ek0; kt1[i] = k1[i] * ek1;
        if (MODE == 1) {
            const float eq0 = __expf(G0 - gm0), eq1 = __expf(G1 - gm1);
            const float q0 = bf_lo(qq[i]), q1 = bf_hi(qq[i]);
            const float sq0 = q0 * sigmoidf_(q0) * 0.08838834764831845f, sq1 = q1 * sigmoidf_(q1) * 0.08838834764831845f;
            *(LAS unsigned*)(QT + (8 * rg + i) * PQ + d0) = cvt_pk_bf16(sq0 * eq0, sq1 * eq1);
            *(LAS unsigned*)(KT + (8 * rg + i) * PQ + d0) = cvt_pk_bf16(kt0[i], kt1[i]);
        }
    }
    {
        u32x4 w0, w1;
        w0.x = cvt_pk_bf16(kt0[0], kt0[1]); w0.y = cvt_pk_bf16(kt0[2], kt0[3]); w0.z = cvt_pk_bf16(kt0[4], kt0[5]); w0.w = cvt_pk_bf16(kt0[6], kt0[7]);
        w1.x = cvt_pk_bf16(kt1[0], kt1[1]); w1.y = cvt_pk_bf16(kt1[2], kt1[3]); w1.z = cvt_pk_bf16(kt1[4], kt1[5]); w1.w = cvt_pk_bf16(kt1[6], kt1[7]);
        *(LAS u32x4*)(KTT + d0 * PS + 8 * rg) = w0; *(LAS u32x4*)(KTT + (d0 + 1) * PS + 8 * rg) = w1;
    }
    {
        u32x4 w0, w1;
        w0.x = (vv[0] & 0xffffu) | (vv[1] << 16); w0.y = (vv[2] & 0xffffu) | (vv[3] << 16); w0.z = (vv[4] & 0xffffu) | (vv[5] << 16); w0.w = (vv[6] & 0xffffu) | (vv[7] << 16);
        w1.x = (vv[0] >> 16) | (vv[1] & 0xffff0000u); w1.y = (vv[2] >> 16) | (vv[3] & 0xffff0000u); w1.z = (vv[4] >> 16) | (vv[5] & 0xffff0000u); w1.w = (vv[6] >> 16) | (vv[7] & 0xffff0000u);
        *(LAS u32x4*)(VT + d0 * PS + 8 * rg) = w0; *(LAS u32x4*)(VT + (d0 + 1) * PS + 8 * rg) = w1;
    }
    if (rg == 0) {
        LAS float* EGM = (LAS float*)(lds + L_EGM); LAS float* EGL = (LAS float*)(lds + L_EGL); LAS float* EGD = (LAS float*)(lds + L_EGD);
        if (MODE == 1) *(LAS f32x2*)(EGM + d0) = (f32x2){__expf(gm0), __expf(gm1)};
        *(LAS f32x2*)(EGL + d0) = (f32x2){__expf(gl0 - gm0), __expf(gl1 - gm1)};
        *(LAS f32x2*)(EGD + d0) = (f32x2){__expf(gl0), __expf(gl1)};
    }
    __syncthreads();
}
__device__ __forceinline__ void gla_state_acc(LAS unsigned char* lds, f32x4 (&S)[8]) {
    const int tid = otid(), wid = tid >> 6, lane = tid & 63, fr = lane & 15, fq = lane >> 4;
    const LAS bf16_t* KTT = (const LAS bf16_t*)(lds + L_KTT); const LAS bf16_t* VT = (const LAS bf16_t*)(lds + L_VT); const LAS float* EGL = (const LAS float*)(lds + L_EGL); const LAS float* EGD = (const LAS float*)(lds + L_EGD);
    bf16x8 b[2];
#pragma unroll
    for (int ks = 0; ks < 2; ++ks) b[ks] = *(const LAS bf16x8*)(VT + (16 * wid + fr) * PS + 32 * ks + 8 * fq);
#pragma unroll
    for (int dt = 0; dt < 8; ++dt) {
        f32x4 acc = ozero4();
#pragma unroll
        for (int ks = 0; ks < 2; ++ks) { const bf16x8 a = *(const LAS bf16x8*)(KTT + (16 * dt + fr) * PS + 32 * ks + 8 * fq); acc = __builtin_amdgcn_mfma_f32_16x16x32_bf16(a, b[ks], acc, 0, 0, 0); }
        const f32x4 egl = *(const LAS f32x4*)(EGL + 16 * dt + 4 * fq), egd = *(const LAS f32x4*)(EGD + 16 * dt + 4 * fq);
        S[dt] = S[dt] * egd + acc * egl;
    }
}
__device__ __forceinline__ void gla_super_state(LAS unsigned char* lds, const bf16_t* Z, const float* lb, float* ds_out, float* dsup_out, int r0, int hh, int nch, int nvalid) {
    const int tid = otid(), wid = tid >> 6, lane = tid & 63, fr = lane & 15, fq = lane >> 4;
    LAS float* DSUP = (LAS float*)(lds + L_DSUP); const LAS float* EGD = (const LAS float*)(lds + L_EGD);
    f32x4 S[8];
#pragma unroll
    for (int dt = 0; dt < 8; ++dt) S[dt] = ozero4();
    if (tid < 128) DSUP[tid] = 1.0f;
    GlaIn cur, nxt; gla_load<0>(cur, Z, r0, hh); nxt = cur;
#pragma unroll
    for (int c = 0; c < 4; ++c) {
        if (c < nch) {
            if (c + 1 < nch) gla_load<0>(nxt, Z, r0 + 64 * (c + 1), hh);
            gla_prep<0>(lds, cur, nullptr, lb, nvalid);
            gla_state_acc(lds, S);
            if (tid < 128) DSUP[tid] *= EGD[tid];
            __syncthreads();
            cur = nxt;
        }
    }
#pragma unroll
    for (int dt = 0; dt < 8; ++dt) *(f32x4*)(ds_out + (size_t)(16 * wid + fr) * 128 + 16 * dt + 4 * fq) = S[dt];
    if (tid < 128) dsup_out[tid] = DSUP[tid];
    __syncthreads();
}
__device__ __forceinline__ void gla_super_out(LAS unsigned char* lds, const bf16_t* Z, const float* lb, const float* sst, const float* gnorm, bf16_t* Y, int r0, int hh, int nch, int nvalid) {
    const int tid = otid(), wid = tid >> 6, lane = tid & 63, fr = lane & 15, fq = lane >> 4;
    const LAS bf16_t* QT = (const LAS bf16_t*)(lds + L_QT); const LAS bf16_t* KT = (const LAS bf16_t*)(lds + L_KT); const LAS bf16_t* VT = (const LAS bf16_t*)(lds + L_VT);
    LAS bf16_t* AL = (LAS bf16_t*)(lds + L_AL); LAS bf16_t* STL = (LAS bf16_t*)(lds + L_STL); const LAS float* EGM = (const LAS float*)(lds + L_EGM); LAS float* SSQL = (LAS float*)(lds + L_SSQL);
    f32x4 S[8];
#pragma unroll
    for (int dt = 0; dt < 8; ++dt) S[dt] = sst ? *(const f32x4*)(sst + (size_t)(16 * wid + fr) * 128 + 16 * dt + 4 * fq) : ozero4();
    GlaIn cur, nxt; gla_load<1>(cur, Z, r0, hh); nxt = cur;
    const int tt = wid & 3, vt0 = 4 * (wid >> 2);
#pragma unroll
    for (int c = 0; c < 4; ++c) {
        if (c < nch) {
            const int rc = r0 + 64 * c;
            if (c + 1 < nch) gla_load<1>(nxt, Z, rc + 64, hh);
            u32x2 gate_r[4];
            { const bf16_t* zg = Z + (size_t)(rc + 16 * tt + fr) * DIN + 2048 + hh * 128;
#pragma unroll
              for (int j = 0; j < 4; ++j) gate_r[j] = *(const u32x2*)(zg + 16 * (vt0 + j) + 4 * fq); }
            gla_prep<1>(lds, cur, Z + (size_t)rc * DIN + 512 + hh * 128, lb, nvalid);
#pragma unroll
            for (int dt = 0; dt < 8; ++dt) { const f32x4 e = *(const LAS f32x4*)(EGM + 16 * dt + 4 * fq); u32x2 w; w.x = cvt_pk_bf16(S[dt][0] * e[0], S[dt][1] * e[1]); w.y = cvt_pk_bf16(S[dt][2] * e[2], S[dt][3] * e[3]);
                *(LAS u32x2*)(STL + (16 * wid + fr) * PQ + 16 * dt + 4 * fq) = w; }
#pragma unroll
            for (int sti = 0; sti < 2; ++sti) {
                const int st = 2 * (wid >> 2) + sti;
                f32x4 acc = ozero4();
                if (st <= tt) {
#pragma unroll
                    for (int ks = 0; ks < 4; ++ks) { const bf16x8 a = *(const LAS bf16x8*)(KT + (16 * st + fr) * PQ + 32 * ks + 8 * fq), b = *(const LAS bf16x8*)(QT + (16 * tt + fr) * PQ + 32 * ks + 8 * fq);
                        acc = __builtin_amdgcn_mfma_f32_16x16x32_bf16(a, b, acc, 0, 0, 0); }
                }
                const int t = 16 * tt + fr, s0 = 16 * st + 4 * fq;
                float cc[4];
#pragma unroll
                for (int reg = 0; reg < 4; ++reg) cc[reg] = (st <= tt && s0 + reg <= t) ? acc[reg] : 0.f;
                u32x2 w; w.x = cvt_pk_bf16(cc[0], cc[1]); w.y = cvt_pk_bf16(cc[2], cc[3]);
                *(LAS u32x2*)(AL + t * PS + s0) = w;
            }
            __syncthreads();
            bf16x8 bA[2], bQ[4];
#pragma unroll
            for (int ks = 0; ks < 2; ++ks) bA[ks] = *(const LAS bf16x8*)(AL + (16 * tt + fr) * PS + 32 * ks + 8 * fq);
#pragma unroll
            for (int ks = 0; ks < 4; ++ks) bQ[ks] = *(const LAS bf16x8*)(QT + (16 * tt + fr) * PQ + 32 * ks + 8 * fq);
            f32x4 o[4]; float ss = 0.f;
#pragma unroll
            for (int j = 0; j < 4; ++j) {
                const int vt = vt0 + j; f32x4 acc = ozero4();
#pragma unroll
                for (int ks = 0; ks < 2; ++ks) { const bf16x8 a = *(const LAS bf16x8*)(VT + (16 * vt + fr) * PS + 32 * ks + 8 * fq); acc = __builtin_amdgcn_mfma_f32_16x16x32_bf16(a, bA[ks], acc, 0, 0, 0); }
#pragma unroll
                for (int ks = 0; ks < 4; ++ks) { const bf16x8 a = *(const LAS bf16x8*)(STL + (16 * vt + fr) * PQ + 32 * ks + 8 * fq); acc = __builtin_amdgcn_mfma_f32_16x16x32_bf16(a, bQ[ks], acc, 0, 0, 0); }
                o[j] = acc; ss += (acc[0] * acc[0] + acc[1] * acc[1]) + (acc[2] * acc[2] + acc[3] * acc[3]);
            }
            ss += __shfl_xor(ss, 16); ss += __shfl_xor(ss, 32);
            if (fq == 0) SSQL[(wid >> 2) * 64 + 16 * tt + fr] = ss;
            __syncthreads();
            const int t = 16 * tt + fr;
            const float rn = __builtin_amdgcn_rsqf((SSQL[t] + SSQL[64 + t]) * (1.0f / 128.0f) + EPS);
            if (t < nvalid) {
                bf16_t* yo = Y + (size_t)(rc + t) * D + 512 + hh * 128;
#pragma unroll
                for (int j = 0; j < 4; ++j) {
                    const int v = 16 * (vt0 + j) + 4 * fq;
                    const u32x2 gt = gate_r[j]; const f32x4 gn = *(const f32x4*)(gnorm + v);
                    const float g0 = bf_lo(gt.x), g1 = bf_hi(gt.x), g2 = bf_lo(gt.y), g3 = bf_hi(gt.y);
                    u32x2 w; w.x = cvt_pk_bf16(o[j][0] * rn * gn[0] * g0 * sigmoidf_(g0), o[j][1] * rn * gn[1] * g1 * sigmoidf_(g1));
                    w.y = cvt_pk_bf16(o[j][2] * rn * gn[2] * g2 * sigmoidf_(g2), o[j][3] * rn * gn[3] * g3 * sigmoidf_(g3));
                    *(u32x2*)(yo + v) = w;
                }
            }
            if (c + 1 < nch) gla_state_acc(lds, S);
            __syncthreads();
            cur = nxt;
        }
    }
}
__device__ __forceinline__ void gla_sample(LAS unsigned char* lds, const Params& p, int l, int n, int hh) {
    const int tid = otid();
    const bf16_t* Z = (const bf16_t*)(p.ws + WS_Z); bf16_t* Y = (bf16_t*)(p.ws + WS_Y);
    const float* S0 = p.state_rec + ((size_t)(l * NDB + n) * 4 + hh) * 16384; float* Sout = p.out + O_RS + ((size_t)(l * NDB + n) * 4 + hh) * 16384;
    LAS float* FG = (LAS float*)lds; LAS float* KK = FG + 512; LAS float* QS = KK + 512; LAS float* VV = QS + 512; LAS float* GT = VV + 512; LAS float* RED = GT + 512; LAS float* PART = RED + 64;
    const int r0 = ROW_S0 + 4 * n;
    const int vq = tid & 31, dg = tid >> 5;
    f32x4 S[8];
#pragma unroll
    for (int i = 0; i < 8; ++i) S[i] = *(const f32x4*)(S0 + (size_t)(8 * dg + i) * 128 + 4 * vq);
    {
        const int t = tid >> 7, d = tid & 127; const bf16_t* zr = Z + (size_t)(r0 + t) * DIN + hh * 128 + d;
        const float q = bf1(zr[512]), f = bf1(zr[1024]), v = bf1(zr[1536]), gt = bf1(zr[2048]);
        const float lb = ((const float*)(p.ws + WS_LB))[l * 512 + hh * 128 + d];
        const float e = __expf(-f), s = rcp_(1.0f + e);
        FG[tid] = lb + (1.0f - lb) * s; KK[tid] = (1.0f - lb) * e * s; QS[tid] = q * sigmoidf_(q) * 0.08838834764831845f; VV[tid] = v; GT[tid] = gt * sigmoidf_(gt);
    }
    __syncthreads();
#pragma unroll
    for (int t = 0; t < 4; ++t) {
        const f32x4 vv = *(const LAS f32x4*)(VV + t * 128 + 4 * vq); f32x4 po = (f32x4){0.f, 0.f, 0.f, 0.f};
#pragma unroll
        for (int i = 0; i < 8; ++i) { const int d = 8 * dg + i; S[i] = S[i] * FG[t * 128 + d] + vv * KK[t * 128 + d]; po += S[i] * QS[t * 128 + d]; }
        *(LAS f32x4*)(PART + (dg * 4 + t) * 128 + 4 * vq) = po;
    }
#pragma unroll
    for (int i = 0; i < 8; ++i) *(f32x4*)(Sout + (size_t)(8 * dg + i) * 128 + 4 * vq) = S[i];
    __syncthreads();
    {
        const int t = tid >> 7, v = tid & 127; float o = 0.f;
#pragma unroll
        for (int g = 0; g < 16; ++g) o += PART[(g * 4 + t) * 128 + v];
        const float s = wave_sum(o * o);
        if ((tid & 63) == 0) RED[tid >> 6] = s;
        __syncthreads();
        const float rn = __builtin_amdgcn_rsqf((RED[2 * t] + RED[2 * t + 1]) * (1.0f / 128.0f) + EPS);
        const float gn = p.rec_norm_g[l * 128 + v];
        const float y = o * rn * gn * GT[tid];
        Y[(size_t)(r0 + t) * D + 512 + hh * 128 + v] = (bf16_t)(cvt_pk_bf16(y, 0.f) & 0xffffu);
    }
    __syncthreads();
}
__device__ __forceinline__ void gla_scan(const Params& p, int l) {
    const float* DS = (const float*)(p.ws + WS_DS); const float* DV = (const float*)(p.ws + WS_DV); float* SST = (float*)(p.ws + WS_SST);
    for (int g = blockIdx.x * NTHR + otid(); g < 32 * 128 * 32; g += gridDim.x * NTHR) {
        const int dq = g & 31, v = (g >> 5) & 127, bh = g >> 12, hh = bh & 3;
        const size_t eo = (size_t)v * 128 + 4 * dq;
        f32x4 S = *(const f32x4*)(DS + (size_t)(NRUN + hh) * 16384 + eo);
#pragma unroll
        for (int sc = 0; sc < 8; ++sc) {
            const int it = bh * 8 + sc;
            *(f32x4*)(SST + (size_t)it * 16384 + eo) = S;
            S = S * *(const f32x4*)(DV + (size_t)it * 128 + 4 * dq) + *(const f32x4*)(DS + (size_t)it * 16384 + eo);
        }
        float* ro = p.out + O_RP + ((size_t)(l * NB + (bh >> 2)) * 4 + hh) * 16384 + v;
#pragma unroll
        for (int j = 0; j < 4; ++j) ro[(size_t)(4 * dq + j) * 128] = S[j];
    }
}

__device__ __forceinline__ void conv_fixup(const Params& p, int l, int pm) {
    const float* TAIL = (const float*)(p.ws + WS_TAIL); const float* HEAD = (const float*)(p.ws + WS_HEAD); bf16_t* H = (bf16_t*)(p.ws + WS_H);
    const float* cw = p.conv_w + (size_t)l * 3 * DFF; const float* cb = p.conv_b + (size_t)l * DFF;
    const int src = (pm & 7) == 0 ? 66 : pm - 1;
    const float* t0 = TAIL + (size_t)src * 2 * DFF; const float* t1 = t0 + DFF;
    const float* a0 = HEAD + (size_t)pm * 4 * DFF; const float* b0 = a0 + DFF; const float* a1 = a0 + 2 * DFF; const float* b1 = a0 + 3 * DFF;
    for (int j = 2 * otid(); j < DFF; j += 2 * NTHR) {
        const f32x2 T0 = *(const f32x2*)(t0 + j), T1 = *(const f32x2*)(t1 + j), A0 = *(const f32x2*)(a0 + j), B0 = *(const f32x2*)(b0 + j), A1 = *(const f32x2*)(a1 + j), B1 = *(const f32x2*)(b1 + j);
        const f32x2 W0 = *(const f32x2*)(cw + j), W1 = *(const f32x2*)(cw + DFF + j), W2 = *(const f32x2*)(cw + 2 * DFF + j), CB = *(const f32x2*)(cb + j);
        const pg8::f32x2 g0 = pg8::gelu_pk(CB + W0 * T0 + W1 * T1 + W2 * A0), g1 = pg8::gelu_pk(CB + W0 * T1 + W1 * A0 + W2 * A1);
        *(unsigned*)(H + (size_t)(pm * 256) * DFF + j) = cvt_pk_bf16(g0.x * B0[0], g0.y * B0[1]);
        *(unsigned*)(H + (size_t)(pm * 256 + 1) * DFF + j) = cvt_pk_bf16(g1.x * B1[0], g1.y * B1[1]);
    }
}

__device__ __forceinline__ void final_norm(const Params& p) {
    const int tid = otid(), lane = tid & 63, wave = tid >> 6;
    const float* XRES = (const float*)(p.ws + WS_XRES); const float* SF = (const float*)(p.ws + WS_SSQ) + (size_t)8 * MP * 16;
    f32x4 gfin[4];
#pragma unroll
    for (int j = 0; j < 4; ++j) gfin[j] = *(const f32x4*)(p.final_g + 4 * lane + 256 * j);
    for (int r = blockIdx.x * 8 + wave; r < ROW_M0; r += gridDim.x * 8) {
        float sq = 0.f;
#pragma unroll
        for (int k = 0; k < 4; ++k) { const f32x4 q = *(const f32x4*)(SF + (size_t)r * 16 + 4 * k); sq += (q[0] + q[1]) + (q[2] + q[3]); }
        const float rs = 1.0f / sqrtf(sq * (1.0f / 1024.0f) + EPS);
        float* o = r < ROW_S0 ? p.out + O_YP + (size_t)r * D : p.out + O_YS + (size_t)(r - ROW_S0) * D;
#pragma unroll
        for (int j = 0; j < 4; ++j) { const f32x4 x = *(const f32x4*)(XRES + (size_t)r * D + 4 * lane + 256 * j); *(f32x4*)(o + 4 * lane + 256 * j) = x * rs * gfin[j]; }
    }
}

#ifndef MK_DUP
#define MK_DUP 0
#endif
#ifndef MK_CHAIN
#define MK_CHAIN 0
#endif
__global__ void __launch_bounds__(NTHR, 2) hymba_fwd(Params p) {
    extern __shared__ __attribute__((aligned(16))) unsigned char lds_raw[];
    LAS unsigned char* lds = (LAS unsigned char*)lds_raw;
    const int G = gridDim.x, bid = blockIdx.x;
#define WSP(T, off) ((T*)(p.ws + (off)))
    if (threadIdx.x < 64) ((LAS unsigned*)(lds + MISC_OFF))[threadIdx.x] = 0u;
    __syncthreads();
    (void)xcd_barrier_post((unsigned*)(p.ws + WS_CTL) + CW_BAR, (volatile LAS unsigned*)(lds + MISC_OFF) + 8);
#define GRID_SYNC() do { XcdBarrier b_; b_.bar = (unsigned*)(p.ws + WS_CTL) + CW_BAR; b_.x = xb_xcc_id(); b_.st = (volatile LAS unsigned*)(lds + MISC_OFF) + 8; xcd_barrier(b_); } while (0)

    prologue(p, lds, 3);
    GRID_SYNC();
#if MK_DUP == 1 || MK_DUP == 6 || MK_DUP == 7 || MK_DUP == 8
    prologue(p, lds, MK_DUP == 1 ? 3 : (MK_DUP == 6 ? 1 : (MK_DUP == 7 ? 2 : 0)));
    GRID_SYNC();
#endif

    const bool chain = (G == 256) && MK_CHAIN;
    unsigned* const CNT = (unsigned*)(p.ws + WS_CTL) + CW_CNT; unsigned* const TMO = (unsigned*)(p.ws + WS_CTL);
    auto gemm1 = [&](int l, bool dealt_chain) {
        pg8::Gemm g{WSP(const bf16_t, WS_XB), WSP(const bf16_t, WS_WIN) + (size_t)l * DIN * D, MP, DIN, D}; pg8::ChainOrder S;
        if (dealt_chain) { const int vc = bid < 78 ? bid : (bid >= 90 ? bid - 12 : -1), e = vc - 152; const bool ex = vc >= 152 && vc < 182;
            S.init(64 * 256, DIN, 244, vc, ex ? 64 + e / 10 : -1, ex ? e % 10 : 0); S.dep = CNT + (size_t)(((l - 1) * 3 + 2) * 67) * 64; S.need = 32u; S.dep_kind = 1; S.tmo = TMO; }
        else S.init(MP, DIN, G, bid, -1, 0);
        pg8::EpiScaleBf16 E{WSP(bf16_t, WS_Z), DIN, WSP(const float, WS_SSQ) + (size_t)(2 * l) * MP * 16};
        pg8::gemm_phase<pg8::EpiScaleBf16, pg8::ChainOrder, true, true>(lds, g, S, E);
    };
    gemm1(0, false);
    GRID_SYNC();

    for (int l = 0; l < DEPTH; ++l) {
        for (int rep = 0; rep < (MK_DUP == 4 ? 2 : 1); ++rep) {
            constexpr int N_A = NGITEM, N_B = NDB * 4, N_C = 513, N_D = 256, N_ALL = N_A + N_B + N_C + N_D + 1;
            for (int r = obid(); r < N_A; r += G) {
                const int hh = r < NRUN ? (r >> 3) & 3 : r - NRUN, r0 = r < NRUN ? (r >> 5) * SEQ + (r & 7) * 256 : ROW_M0;
                gla_super_state(lds, WSP(const bf16_t, WS_Z), WSP(const float, WS_LB) + l * 512 + hh * 128, WSP(float, WS_DS) + (size_t)r * 16384, WSP(float, WS_DV) + (size_t)r * 128, r0, hh, r < NRUN ? 4 : 1, r < NRUN ? 64 : NMETA);
            }
            for (int it = obid(); it < N_ALL; it += G) {
                int r = it;
                if (r < N_A) continue;
                r -= N_A;
                if (r < N_B) { gla_sample(lds, p, l, r >> 2, r & 3); continue; } r -= N_B;
                if (r < N_C) { pool_item(p, l, r, lds); continue; } r -= N_C;
                if (r < N_D) { pool_sample_item(p, l, r); continue; } r -= N_D;
                {
                    for (int i = otid(); i < (MP - MROWS) * D / 8; i += NTHR) *(u32x4*)(WSP(bf16_t, WS_Y) + (size_t)MROWS * D + 8 * i) = ozero4u();
                }
            }
            GRID_SYNC();
        }
        gla_scan(p, l);
        GRID_SYNC();
#if MK_DUP == 3
        gla_scan(p, l);
        GRID_SYNC();
#endif
        for (int rep = 0; rep < (MK_DUP == 5 ? 2 : 1); ++rep) {
        for (int r = obid(); r < NGITEM; r += G) {
            const int hh = r < NRUN ? (r >> 3) & 3 : r - NRUN, r0 = r < NRUN ? (r >> 5) * SEQ + (r & 7) * 256 : ROW_M0;
            gla_super_out(lds, WSP(const bf16_t, WS_Z), WSP(const float, WS_LB) + l * 512 + hh * 128, r < NRUN ? WSP(const float, WS_SST) + (size_t)r * 16384 : nullptr, p.rec_norm_g + l * 128, WSP(bf16_t, WS_Y), r0, hh, r < NRUN ? 4 : 1, r < NRUN ? 64 : NMETA);
        }
        GRID_SYNC();
        }
        {
            pg8::Gemm g{WSP(const bf16_t, WS_Y), WSP(const bf16_t, WS_WOUT) + (size_t)l * D * D, MP, D, D}; pg8::ChainOrder S;
            if (chain) { S.init(64 * 256, D, 256, bid, bid < 12 ? 64 + bid / 4 : -1, bid & 3); S.sig = CNT + (size_t)((l * 3 + 0) * 67) * 64; S.tmo = TMO; } else S.init(MP, D, G, bid, -1, 0);
            pg8::EpiRes E{WSP(float, WS_XRES), WSP(bf16_t, WS_XB), WSP(float, WS_SSQ) + (size_t)(2 * l + 1) * MP * 16};
            pg8::gemm_phase<pg8::EpiRes, pg8::ChainOrder, true, true>(lds, g, S, E);
        }
        if (!chain || MK_DUP == 9) GRID_SYNC();
        {
            pg8::Gemm g{WSP(const bf16_t, WS_XB), WSP(const bf16_t, WS_WAB) + (size_t)l * NAB * D, MP, NAB, D}; pg8::ChainOrder S;
            if (chain) { const int e = bid - 12; const bool ex = bid >= 12 && bid < 78; S.init(64 * 256, NAB, 256, (bid + 128) & 255, ex ? 64 + e / 22 : -1, ex ? e % 22 : 0);
                S.dep = CNT + (size_t)((l * 3 + 0) * 67) * 64; S.need = 32u; S.dep_kind = 1; S.sig = CNT + (size_t)((l * 3 + 1) * 67) * 64; S.tmo = TMO; } else S.init(MP, NAB, G, bid, -1, 0);
            pg8::EpiConv E{WSP(bf16_t, WS_H), WSP(const float, WS_SSQ) + (size_t)(2 * l + 1) * MP * 16, p.conv_w + (size_t)l * 3 * DFF, p.conv_b + (size_t)l * DFF, WSP(float, WS_TAIL), WSP(float, WS_HEAD),
                           p.state_conv + (size_t)l * NDB * 2 * DFF, p.out + O_CP + (size_t)l * NB * 2 * DFF, p.out + O_CS + (size_t)l * NDB * 2 * DFF, (LAS float*)(lds + HALO_OFF)};
            pg8::gemm_phase<pg8::EpiConv, pg8::ChainOrder, true, true>(lds, g, S, E);
        }
        if (!chain || MK_DUP == 9) GRID_SYNC();
        {
            pg8::Gemm g{WSP(const bf16_t, WS_H), WSP(const bf16_t, WS_WDN) + (size_t)l * D * DFF, MP, D, DFF}; pg8::ChainOrder S;
            if (chain) { const int e = bid - 78; const bool ex = bid >= 78 && bid < 90; S.init(64 * 256, D, 256, bid, ex ? 64 + e / 4 : -1, ex ? e & 3 : 0);
                S.dep = CNT + (size_t)((l * 3 + 1) * 67) * 64; S.need = 176u; S.dep_kind = 2; S.sig = CNT + (size_t)((l * 3 + 2) * 67) * 64; S.tmo = TMO;
                S.fx = pg8::FixCtx{WSP(const float, WS_TAIL), WSP(const float, WS_HEAD), WSP(bf16_t, WS_H), p.conv_w + (size_t)l * 3 * DFF, p.conv_b + (size_t)l * DFF}; }
            else { S.init(MP, D, G, bid, -1, 0); pg8::Unit uu; for (int i = 0; S.next(i, uu); ++i) if (uu.pm < 64) conv_fixup(p, l, uu.pm); asm volatile("s_waitcnt vmcnt(0)" ::: "memory"); __syncthreads(); }
            pg8::EpiRes E{WSP(float, WS_XRES), WSP(bf16_t, WS_XB), WSP(float, WS_SSQ) + (size_t)(2 * l + 2) * MP * 16};
            pg8::gemm_phase<pg8::EpiRes, pg8::ChainOrder, true, true>(lds, g, S, E);
        }
        if (l + 1 < DEPTH) { if (!chain || MK_DUP == 9) GRID_SYNC(); gemm1(l + 1, chain); }
        GRID_SYNC();
    }
    final_norm(p);
}
}

extern "C" void kernel_launch(void* const* d_in, const int* in_sizes, int n_in, void* d_out, int out_size, void* d_ws, size_t ws_size, hipStream_t stream) {
    static int grid = 0;
    if (grid == 0) {
        if (n_in != 20 || ws_size < mk::WS_TOTAL) { fprintf(stderr, "kernel_launch: unexpected n_in %d / ws_size %zu\n", n_in, ws_size); grid = -1; return; }
        int dev = 0, cus = 0, per_cu = 0;
        hipGetDevice(&dev); hipDeviceGetAttribute(&cus, hipDeviceAttributeMultiprocessorCount, dev);
        hipFuncSetAttribute((const void*)mk::hymba_fwd, hipFuncAttributeMaxDynamicSharedMemorySize, mk::LDS_BYTES);
        hipOccupancyMaxActiveBlocksPerMultiprocessor(&per_cu, (const void*)mk::hymba_fwd, mk::NTHR, mk::LDS_BYTES);
        if (per_cu < 1) { fprintf(stderr, "kernel_launch: occupancy query says %d blocks per CU\n", per_cu); per_cu = 1; }
        grid = cus * 1;
    }
    if (grid < 0) return;
    mk::Params p{};
    p.x_prompt = (const float*)d_in[0]; p.x_sample = (const float*)d_in[1]; p.state_pool = (const float*)d_in[2]; p.state_rec = (const float*)d_in[3]; p.state_conv = (const float*)d_in[4];
    p.meta = (const float*)d_in[5]; p.norm1_g = (const float*)d_in[6]; p.w_in = (const float*)d_in[7]; p.w_pool = (const float*)d_in[8]; p.pool_scale = (const float*)d_in[9];
    p.lb_raw = (const float*)d_in[10]; p.rec_norm_g = (const float*)d_in[11]; p.w_out = (const float*)d_in[12]; p.norm2_g = (const float*)d_in[13]; p.w_a = (const float*)d_in[14];
    p.w_b = (const float*)d_in[15]; p.conv_w = (const float*)d_in[16]; p.conv_b = (const float*)d_in[17]; p.w_down = (const float*)d_in[18]; p.final_g = (const float*)d_in[19];
    p.out = (float*)d_out; p.ws = (unsigned char*)d_ws;
    if (hipMemsetAsync((char*)d_ws + mk::WS_CTL, 0, mk::CTL_ZERO_BYTES, stream) != hipSuccess) { fprintf(stderr, "kernel_launch: memset of the control words failed\n"); return; }
    hipLaunchKernelGGL(mk::hymba_fwd, dim3(grid), dim3(mk::NTHR), mk::LDS_BYTES, stream, p);
    const hipError_t e = hipPeekAtLastError();
    if (e != hipSuccess) fprintf(stderr, "kernel_launch: launch failed: %s (grid %d)\n", hipGetErrorString(e), grid);
}
```
